# Optimizing an MI355X kernel written in HIP

```python
import jax, jax.numpy as jnp
from jax import lax
import numpy as np

D_MODEL = 1024
BATCH = 4
SEQ = 4096
DEPTH = 4
DEC_BATCH = 32
DEC_SEQ = 4
PAST_LEN = 8192
PAGE_SIZE = 128

N_MIXERS = 2
N_LAYERS_A = (DEPTH + 1) // 2
N_LAYERS_B = DEPTH // 2
HEAD_DIM = 64
N_SLOTS = 8
DIL_WINDOWS = (128, 512, 2048)
DIL_RATES = (1, 4, 16)
N_GROUPS_A = len(DIL_WINDOWS)
QKV_WIDTH = 3 * N_GROUPS_A * N_SLOTS * HEAD_DIM
A_WIDTH = N_SLOTS * HEAD_DIM
BAND_BLOCK = 128
CHUNK = 128
D_FFN_B = 6 * D_MODEL
D_V = D_FFN_B // 2
N_GROUPS_B = 8
GROUP_B = D_V // N_GROUPS_B
D_FF = 2816
RMS_EPS = 1e-6
LN_EPS = 1e-5

kernel_name = "dilated_window_gmlp_macaron_hybrid_step"


def rmsnorm(x, g):
    xf = x.astype(jnp.float32)
    y = xf * lax.rsqrt(jnp.mean(xf * xf, axis=-1, keepdims=True) + RMS_EPS)
    return (y * g.astype(jnp.float32)).astype(x.dtype)


def layernorm(x, g, b):
    xf = x.astype(jnp.float32)
    mu = jnp.mean(xf, axis=-1, keepdims=True)
    xc = xf - mu
    y = xc * lax.rsqrt(jnp.mean(xc * xc, axis=-1, keepdims=True) + LN_EPS)
    return (y * g.astype(jnp.float32) + b.astype(jnp.float32)).astype(x.dtype)


def swiglu(x, w_in, w_out):
    gate, up = jnp.split(x @ w_in, 2, axis=-1)
    return (jax.nn.silu(gate) * up) @ w_out


def project_qkv(h, w_qkv):
    b, s, _ = h.shape
    qkv = (h @ w_qkv).reshape(b, s, 3, N_GROUPS_A, N_SLOTS, HEAD_DIM)
    return qkv[:, :, 0], qkv[:, :, 1], qkv[:, :, 2]


def band_attention(q, k, v, dil, n_back):
    b, s, h, dh = q.shape
    s_sub = s // dil
    nb = -(-s_sub // BAND_BLOCK)
    pad = nb * BAND_BLOCK - s_sub

    def to_sub(a):
        a = a.reshape(b, s_sub, dil, h, dh).transpose(0, 2, 1, 3, 4)
        a = jnp.pad(a, ((0, 0), (0, 0), (0, pad), (0, 0), (0, 0)))
        return a.reshape(b, dil, nb, BAND_BLOCK, h, dh)

    def with_prev(a):
        prev = jnp.pad(a, ((0, 0), (0, 0), (1, 0), (0, 0), (0, 0), (0, 0)))[:, :, :nb]
        return jnp.concatenate([prev, a], axis=3)

    qs = to_sub(q)
    kb = with_prev(to_sub(k))
    vb = with_prev(to_sub(v))
    scores = jnp.einsum('brnqhd,brnkhd->brnhqk', qs, kb).astype(jnp.float32) * (HEAD_DIM ** -0.5)
    qi = jnp.arange(BAND_BLOCK)[:, None]
    ki = jnp.arange(2 * BAND_BLOCK)[None, :]
    dist = BAND_BLOCK + qi - ki
    band = (dist >= 0) & (dist <= n_back)
    key_sub = (jnp.arange(nb)[:, None] - 1) * BAND_BLOCK + ki
    mask = band[None] & (key_sub >= 0)[:, None, :]
    scores = jnp.where(mask[:, None], scores, -jnp.inf)
    m = jnp.max(scores, axis=-1, keepdims=True)
    p = jnp.exp(scores - m)
    denom = jnp.sum(p, axis=-1, keepdims=True)
    o = jnp.einsum('brnhqk,brnkhd->brnqhd', (p / denom).astype(v.dtype), vb).astype(jnp.float32)
    lse = (m + jnp.log(denom))[..., 0]
    o = o.reshape(b, dil, nb * BAND_BLOCK, h, dh)[:, :, :s_sub]
    o = o.transpose(0, 2, 1, 3, 4).reshape(b, s, h, dh)
    lse = lse.transpose(0, 1, 2, 4, 3).reshape(b, dil, nb * BAND_BLOCK, h)[:, :, :s_sub]
    lse = lse.transpose(0, 2, 1, 3).reshape(b, s, h)
    return o, lse


def cached_attention(q, k_new, v_new, k_buf, v_buf, dil, n_back):
    t = q.shape[1]
    buf_len = k_buf.shape[1]
    k_all = jnp.concatenate([k_buf, k_new], axis=1)
    v_all = jnp.concatenate([v_buf, v_new], axis=1)
    idx = buf_len + jnp.arange(t)[:, None] - dil * jnp.arange(n_back + 1)[None, :]
    valid = idx >= 0
    idx = jnp.maximum(idx, 0)
    kg = k_all[:, idx]
    vg = v_all[:, idx]
    scores = jnp.einsum('bthd,btjhd->bthj', q, kg).astype(jnp.float32) * (HEAD_DIM ** -0.5)
    scores = jnp.where(valid[None, :, None, :], scores, -jnp.inf)
    m = jnp.max(scores, axis=-1, keepdims=True)
    p = jnp.exp(scores - m)
    denom = jnp.sum(p, axis=-1, keepdims=True)
    o = jnp.einsum('bthj,btjhd->bthd', (p / denom).astype(v_new.dtype), vg).astype(jnp.float32)
    lse = (m + jnp.log(denom))[..., 0]
    return o, lse


def merge_groups(outs, lses, w_out, dtype):
    o = jnp.stack(outs, axis=2)
    wts = jax.nn.softmax(jnp.stack(lses, axis=2), axis=2)
    y = jnp.einsum('bsgh,bsghd->bshd', wts, o)
    b, s = y.shape[:2]
    return y.reshape(b, s, A_WIDTH).astype(dtype) @ w_out


def dilated_mixer_prompt(h, w_qkv, w_out):
    q, k, v = project_qkv(h, w_qkv)
    s = h.shape[1]
    outs, lses, rows = [], [], []
    for g in range(N_GROUPS_A):
        win, dil = DIL_WINDOWS[g], DIL_RATES[g]
        o, lse = band_attention(q[:, :, g], k[:, :, g], v[:, :, g], dil, win // dil)
        outs.append(o)
        lses.append(lse)
        keep = min(win, s)
        rows.append(jnp.stack([k[:, s - keep:, g], v[:, s - keep:, g]], axis=2))
    return merge_groups(outs, lses, w_out, h.dtype), rows


def dilated_mixer_sample(h, bufs, w_qkv, w_out):
    q, k, v = project_qkv(h, w_qkv)
    outs, lses, rows = [], [], []
    for g in range(N_GROUPS_A):
        win, dil = DIL_WINDOWS[g], DIL_RATES[g]
        buf = bufs[g]
        o, lse = cached_attention(q[:, :, g], k[:, :, g], v[:, :, g],
                                  buf[:, :, 0], buf[:, :, 1], dil, win // dil)
        outs.append(o)
        lses.append(lse)
        rows.append(jnp.stack([k[:, :, g], v[:, :, g]], axis=2))
    return merge_groups(outs, lses, w_out, h.dtype), rows


def chunk_gmlp(h, w_uv, ln_g, ln_b, w_s, b_s, w_out):
    b, s, _ = h.shape
    u, v = jnp.split(jax.nn.gelu(h @ w_uv), 2, axis=-1)
    v = layernorm(v, ln_g, ln_b)
    clen = min(s, CHUNK)
    n = s // clen
    causal = jnp.tril(jnp.ones((clen, clen), dtype=bool))
    w = jnp.where(causal[None], w_s[:, :clen, :clen], 0)
    vr = v.reshape(b, n, clen, N_GROUPS_B, GROUP_B)
    mixed = jnp.einsum('gts,bnsgc->bntgc', w, vr) + b_s[:, :clen].T[None, None, :, :, None]
    return (u * mixed.reshape(b, s, D_V)) @ w_out, v


def setup_inputs(seed: int = 0) -> dict:
    key = jax.random.key(seed)
    ks = jax.random.split(key, 24)
    f32 = jnp.float32

    def nrm(k, shape, scale=1.0):
        return jax.random.normal(k, shape, f32) * scale

    def gain(k, shape):
        return 1.0 + 0.02 * jax.random.normal(k, shape, f32)

    return {
        "x_prompt": nrm(ks[0], (BATCH, SEQ, D_MODEL)),
        "x_sample": nrm(ks[1], (DEC_BATCH, DEC_SEQ, D_MODEL)),
        "cache_kv_w128": nrm(ks[2], (N_LAYERS_A, DEC_BATCH, min(DIL_WINDOWS[0], PAST_LEN), 2, N_SLOTS, HEAD_DIM)),
        "cache_kv_w512": nrm(ks[3], (N_LAYERS_A, DEC_BATCH, min(DIL_WINDOWS[1], PAST_LEN), 2, N_SLOTS, HEAD_DIM)),
        "cache_kv_w2048": nrm(ks[4], (N_LAYERS_A, DEC_BATCH, min(DIL_WINDOWS[2], PAST_LEN), 2, N_SLOTS, HEAD_DIM)),
        "norm_ffn1": gain(ks[5], (DEPTH, D_MODEL)),
        "w_ffn1_in": nrm(ks[6], (DEPTH, D_MODEL, 2 * D_FF), D_MODEL ** -0.5),
        "w_ffn1_out": nrm(ks[7], (DEPTH, D_FF, D_MODEL), D_FF ** -0.5),
        "norm_mix": gain(ks[8], (DEPTH, D_MODEL)),
        "norm_ffn2": gain(ks[9], (DEPTH, D_MODEL)),
        "w_ffn2_in": nrm(ks[10], (DEPTH, D_MODEL, 2 * D_FF), D_MODEL ** -0.5),
        "w_ffn2_out": nrm(ks[11], (DEPTH, D_FF, D_MODEL), D_FF ** -0.5),
        "w_qkv_a": nrm(ks[12], (N_LAYERS_A, D_MODEL, QKV_WIDTH), D_MODEL ** -0.5),
        "w_out_a": nrm(ks[13], (N_LAYERS_A, A_WIDTH, D_MODEL), A_WIDTH ** -0.5),
        "w_uv_b": nrm(ks[14], (N_LAYERS_B, D_MODEL, 2 * D_V), D_MODEL ** -0.5),
        "ln_v_gain": gain(ks[15], (N_LAYERS_B, D_V)),
        "ln_v_bias": nrm(ks[16], (N_LAYERS_B, D_V), 0.02),
        "w_spatial": nrm(ks[17], (N_LAYERS_B, N_GROUPS_B, CHUNK, CHUNK), CHUNK ** -0.5),
        "b_spatial": gain(ks[18], (N_LAYERS_B, N_GROUPS_B, CHUNK)),
        "w_out_b": nrm(ks[19], (N_LAYERS_B, D_V, D_MODEL), D_V ** -0.5),
        "norm_final": gain(ks[20], (D_MODEL,)),
    }


def reference(x_prompt, x_sample, cache_kv_w128, cache_kv_w512, cache_kv_w2048,
              norm_ffn1, w_ffn1_in, w_ffn1_out, norm_mix, norm_ffn2, w_ffn2_in, w_ffn2_out,
              w_qkv_a, w_out_a, w_uv_b, ln_v_gain, ln_v_bias, w_spatial, b_spatial, w_out_b,
              norm_final):
    caches = (cache_kv_w128, cache_kv_w512, cache_kv_w2048)
    xp, xs = x_prompt, x_sample
    kv_prompt = [[] for _ in range(N_GROUPS_A)]
    kv_sample = [[] for _ in range(N_GROUPS_A)]
    v_rows = []
    for i in range(DEPTH):
        li = i // N_MIXERS
        xp = xp + 0.5 * swiglu(rmsnorm(xp, norm_ffn1[i]), w_ffn1_in[i], w_ffn1_out[i])
        xs = xs + 0.5 * swiglu(rmsnorm(xs, norm_ffn1[i]), w_ffn1_in[i], w_ffn1_out[i])
        hp = rmsnorm(xp, norm_mix[i])
        hs = rmsnorm(xs, norm_mix[i])
        if i % N_MIXERS == 0:
            mp, rows_p = dilated_mixer_prompt(hp, w_qkv_a[li], w_out_a[li])
            ms, rows_s = dilated_mixer_sample(hs, [c[li] for c in caches], w_qkv_a[li], w_out_a[li])
            for g in range(N_GROUPS_A):
                kv_prompt[g].append(rows_p[g])
                kv_sample[g].append(rows_s[g])
        else:
            mp, _ = chunk_gmlp(hp, w_uv_b[li], ln_v_gain[li], ln_v_bias[li],
                               w_spatial[li], b_spatial[li], w_out_b[li])
            ms, vs = chunk_gmlp(hs, w_uv_b[li], ln_v_gain[li], ln_v_bias[li],
                                w_spatial[li], b_spatial[li], w_out_b[li])
            v_rows.append(vs)
        xp = xp + mp
        xs = xs + ms
        xp = xp + 0.5 * swiglu(rmsnorm(xp, norm_ffn2[i]), w_ffn2_in[i], w_ffn2_out[i])
        xs = xs + 0.5 * swiglu(rmsnorm(xs, norm_ffn2[i]), w_ffn2_in[i], w_ffn2_out[i])
    y_prompt = rmsnorm(xp, norm_final)
    y_sample = rmsnorm(xs, norm_final)
    kv128_prompt = jnp.stack(kv_prompt[0])
    kv512_prompt = jnp.stack(kv_prompt[1])
    kv2048_prompt = jnp.stack(kv_prompt[2])
    kv128_sample = jnp.stack(kv_sample[0])
    kv512_sample = jnp.stack(kv_sample[1])
    kv2048_sample = jnp.stack(kv_sample[2])
    v_chunk_sample = jnp.stack(v_rows)
    return (y_prompt, y_sample, kv128_prompt, kv512_prompt, kv2048_prompt,
            kv128_sample, kv512_sample, kv2048_sample, v_chunk_sample)
```

```cpp
#include <hip/hip_runtime.h>
#include <cstdio>
#include <cstdint>
namespace pg8 {
#define PG8_LAS __attribute__((address_space(3)))
typedef unsigned short bf16_t;
typedef short bf16x8 __attribute__((ext_vector_type(8)));
typedef float f32x4 __attribute__((ext_vector_type(4)));
typedef unsigned u32x4 __attribute__((ext_vector_type(4)));
constexpr int BM = 256, BK = 64, HALF = 128, HTB = HALF * BK * 2  , STAGE_BYTES = 8 * HTB, NXCD = 8, WGM = 8;

__host__ __device__ __forceinline__ int lds_byte(int r, int c) { const int st = (r >> 4) * 2 + (c >> 5), rr = r & 15, cc = c & 31, ob = rr * 64 + cc * 2; return st * 1024 + (ob ^ (((ob >> 9) & 1) << 5)); }
__host__ __device__ __forceinline__ void stage_rc(int b, int& R, int& C) { const int st = b / 1024, sb = b % 1024, swz = sb ^ (((sb >> 9) & 1) << 5); R = (st >> 1) * 16 + swz / 64; C = (st & 1) * 32 + (swz % 64) / 2; }
__host__ __device__ __forceinline__ int perm32(int rho) { const int n = rho >> 4, i = rho & 15; return 8 * (i >> 2) + 4 * n + (i & 3); }

struct Unit { int pm, pn; };
struct Gemm { const bf16_t* A; const bf16_t* Bt; int M, N, K; };

struct StaticOrder {
    int nM, nN, nwg, G, c;
    __host__ __device__ void init(int M, int N, int G_, int c_) { nM = M / BM; nN = N / BM; nwg = nM * nN; G = G_; c = c_; }
    __host__ __device__ bool next(int i, Unit& u) const {
        const long L = (long)i * G + c; if (L >= nwg) return false;
        int wgid = (int)L; { const int q = nwg / NXCD, r = nwg % NXCD, xcd = wgid % NXCD, off = wgid / NXCD; wgid = (xcd < r ? xcd * (q + 1) : r * (q + 1) + (xcd - r) * q) + off; }
        const int nig = WGM * nN, gid = wgid / nig, fm = gid * WGM, gsz = (nM - fm) < WGM ? (nM - fm) : WGM;
        u.pm = fm + ((wgid % nig) % gsz); u.pn = (wgid % nig) / gsz; return true;
    }
    __device__ __forceinline__ void a_ready(const Unit&) const {}
    __device__ __forceinline__ void done(const Unit&) const {}
};

__device__ __forceinline__ unsigned cvt_pk_bf16(float lo, float hi) { unsigned r; asm volatile("v_cvt_pk_bf16_f32 %0, %1, %2" : "=v"(r) : "v"(lo), "v"(hi)); return r; }
typedef float f32x2 __attribute__((ext_vector_type(2)));
constexpr int XD = 1024;
__device__ __forceinline__ float row_rstd(const float* SS, int r) {
    const f32x4* p = (const f32x4*)(SS + (size_t)r * 16);
    const f32x4 a = p[0], b = p[1], c = p[2], d = p[3];
    const float s = ((a[0] + a[1]) + (a[2] + a[3])) + ((b[0] + b[1]) + (b[2] + b[3])) + ((c[0] + c[1]) + (c[2] + c[3])) + ((d[0] + d[1]) + (d[2] + d[3]));
    return __builtin_amdgcn_rsqf(s * (1.0f / 1024.0f) + 1e-6f);
}
__device__ __forceinline__ float silu_f(float x) { return x * __builtin_amdgcn_rcpf(1.0f + __builtin_amdgcn_exp2f(-1.4426950408889634f * x)); }
__device__ __forceinline__ float gelu_tanh_f(float x) {
    const float a = x * (1.0f + 0.044715f * x * x) * (-2.0f * 0.7978845608028654f * 1.4426950408889634f);
    return x * __builtin_amdgcn_rcpf(1.0f + __builtin_amdgcn_exp2f(a));
}
struct EpiSwiglu {
    static constexpr bool PERM = true, AFTER_DRAIN = false;
    bf16_t* H; const float* SS; int ldh;
    __device__ __forceinline__ void operator()(const f32x4 (&acc)[2][2][4][2], const Unit& u, int wr, int wc, int fr, int fq) const {
        const int row0 = u.pm * BM + wr * 64 + fr, col0 = u.pn * HALF + wc * 32 + 8 * fq;
#pragma unroll
        for (int ai = 0; ai < 2; ++ai)
#pragma unroll
            for (int m = 0; m < 4; ++m) { const int r = row0 + ai * HALF + m * 16; const float rs = row_rstd(SS, r);
                float h[8];
#pragma unroll
                for (int n = 0; n < 2; ++n)
#pragma unroll
                    for (int e = 0; e < 4; ++e) h[4 * n + e] = silu_f(acc[ai][0][m][n][e] * rs) * (acc[ai][1][m][n][e] * rs);
                u32x4 w; w.x = cvt_pk_bf16(h[0], h[1]); w.y = cvt_pk_bf16(h[2], h[3]); w.z = cvt_pk_bf16(h[4], h[5]); w.w = cvt_pk_bf16(h[6], h[7]);
                *(u32x4*)(H + (size_t)r * ldh + col0) = w; }
    }
};
struct EpiResid {
    static constexpr bool PERM = false, AFTER_DRAIN = false;
    float* X; bf16_t* XB; float* SS; float scale;
    __device__ __forceinline__ void operator()(const f32x4 (&acc)[2][2][4][2], const Unit& u, int wr, int wc, int fr, int fq) const {
        typedef unsigned u32x2 __attribute__((ext_vector_type(2)));
        const int row0 = u.pm * BM + wr * 64 + fr, col0 = u.pn * BM + wc * 32 + 4 * fq;
#pragma unroll
        for (int ai = 0; ai < 2; ++ai)
#pragma unroll
            for (int m = 0; m < 4; ++m) { const int r = row0 + ai * HALF + m * 16; float ss = 0.f;
#pragma unroll
                for (int bj = 0; bj < 2; ++bj)
#pragma unroll
                    for (int n = 0; n < 2; ++n) { const size_t off = (size_t)r * XD + col0 + bj * HALF + n * 16;
                        f32x4 x = *(const f32x4*)(X + off); x = x + acc[ai][bj][m][n] * scale; *(f32x4*)(X + off) = x;
                        u32x2 w; w.x = cvt_pk_bf16(x[0], x[1]); w.y = cvt_pk_bf16(x[2], x[3]); *(u32x2*)(XB + off) = w;
                        ss += (x[0] * x[0] + x[1] * x[1]) + (x[2] * x[2] + x[3] * x[3]); }
                ss += __shfl_xor(ss, 16); ss += __shfl_xor(ss, 32);
                if (fq == 0) SS[(size_t)r * 16 + u.pn * 4 + wc] = ss; }
    }
};
struct EpiQkv {
    static constexpr bool PERM = true, AFTER_DRAIN = false;
    bf16_t* QKV; const float* SS; float* out; int li;
    __device__ __forceinline__ void operator()(const f32x4 (&acc)[2][2][4][2], const Unit& u, int wr, int wc, int fr, int fq) const {
        const int row0 = u.pm * BM + wr * 64 + fr;
#pragma unroll
        for (int ai = 0; ai < 2; ++ai)
#pragma unroll
            for (int m = 0; m < 4; ++m) { const int r = row0 + ai * HALF + m * 16; const float rs = row_rstd(SS, r);
#pragma unroll
                for (int bj = 0; bj < 2; ++bj) { const int c0 = u.pn * BM + bj * HALF + wc * 32 + 8 * fq;
                    const f32x4 v0 = acc[ai][bj][m][0] * rs, v1 = acc[ai][bj][m][1] * rs;
                    u32x4 w; w.x = cvt_pk_bf16(v0[0], v0[1]); w.y = cvt_pk_bf16(v0[2], v0[3]); w.z = cvt_pk_bf16(v1[0], v1[1]); w.w = cvt_pk_bf16(v1[2], v1[3]);
                    *(u32x4*)(QKV + (size_t)r * 4608 + c0) = w;
                    const int sec = c0 / 1536;
                    if (sec > 0) { const int cc = c0 - sec * 1536, g = cc >> 9, hh = (cc >> 6) & 7, d = cc & 63, kv = sec - 1;
                        float* dst = nullptr;
                        if (r < 16384) { const int b = r >> 12, pos = r & 4095, keep = 128 << (2 * g), idx = pos - (4096 - keep);
                            const size_t obase = g == 0 ? 16908288u : (g == 1 ? 17956864u : 22151168u);
                            if (idx >= 0) dst = out + obase + ((((size_t)(li * 4 + b) * keep + idx) * 2 + kv) * 8 + hh) * 64 + d;
                        } else if (r < 16512) { const int sr = r - 16384, sb = sr >> 2, t = sr & 3;
                            const size_t obase = g == 0 ? 38928384u : (g == 1 ? 39190528u : 39452672u);
                            dst = out + obase + ((((size_t)(li * 32 + sb) * 4 + t) * 2 + kv) * 8 + hh) * 64 + d; }
                        if (dst) { *(f32x4*)dst = v0; *(f32x4*)(dst + 4) = v1; } } } }
    }
};
struct EpiUv {
    static constexpr bool PERM = true, AFTER_DRAIN = false;
    bf16_t* UV; const float* SS;
    __device__ __forceinline__ void operator()(const f32x4 (&acc)[2][2][4][2], const Unit& u, int wr, int wc, int fr, int fq) const {
        const int row0 = u.pm * BM + wr * 64 + fr;
#pragma unroll
        for (int ai = 0; ai < 2; ++ai)
#pragma unroll
            for (int m = 0; m < 4; ++m) { const int r = row0 + ai * HALF + m * 16; const float rs = row_rstd(SS, r);
#pragma unroll
                for (int bj = 0; bj < 2; ++bj) { const int c0 = u.pn * BM + bj * HALF + wc * 32 + 8 * fq; float h[8];
#pragma unroll
                    for (int n = 0; n < 2; ++n)
#pragma unroll
                        for (int e = 0; e < 4; ++e) h[4 * n + e] = gelu_tanh_f(acc[ai][bj][m][n][e] * rs);
                    u32x4 w; w.x = cvt_pk_bf16(h[0], h[1]); w.y = cvt_pk_bf16(h[2], h[3]); w.z = cvt_pk_bf16(h[4], h[5]); w.w = cvt_pk_bf16(h[6], h[7]);
                    *(u32x4*)(UV + (size_t)r * 6144 + c0) = w; } }
    }
};
template <class Epi, class Sched, bool ALIGN_EPI = false, bool SP2 = false>
__device__ __forceinline__ void gemm_phase(PG8_LAS unsigned char* lds, const Gemm g, const Sched& S, const Epi& E) {
    int tid_ = threadIdx.x; asm volatile("" : "+v"(tid_));
    const int tid = tid_, wid = __builtin_amdgcn_readfirstlane(tid >> 6), lane = tid & 63, wr = wid >> 2, wc = wid & 3, fr = lane & 15, fq = lane >> 4;
    const int K = g.K, nt = K / BK;
    unsigned voffA[2], voffB[2];
#pragma unroll
    for (int i = 0; i < 2; ++i) { int R, C; stage_rc(tid * 16 + i * 8192, R, C); const int Rb = Epi::PERM ? ((R & ~31) + perm32(R & 31)) : R;
        voffA[i] = (unsigned)(R * K + C) * 2u; voffB[i] = (unsigned)(Rb * K + C) * 2u; }
    const size_t kstep = (size_t)(BK * 2);
    const size_t hstep = (size_t)HALF * K * 2;
    const size_t tstep = 2 * hstep;
    const unsigned ldsw = (unsigned)wid * 1024u;
    const int aoff = lds_byte(wr * 64 + fr, fq * 8), boff = lds_byte(wc * 32 + fr, fq * 8);
#define PG8_SA(b, h) (((b) * 2 + (h)) * HTB)
#define PG8_SB(b, h) ((4 + (b) * 2 + (h)) * HTB)
#define PG8_STAGE(bufoff, gbase, voff) do { _Pragma("unroll") for (int _i = 0; _i < 2; ++_i) \
        __builtin_amdgcn_global_load_lds((const unsigned*)((const char*)(gbase) + (voff)[_i]), (PG8_LAS unsigned*)(lds + (bufoff) + ldsw + _i * 8192), 16, 0, 0); } while (0)
#define PG8_LDA(dst, b, h) do { _Pragma("unroll") for (int m = 0; m < 4; ++m) _Pragma("unroll") for (int k = 0; k < 2; ++k) dst[m][k] = *(const PG8_LAS bf16x8*)(lds + PG8_SA(b, h) + aoff + m * 2048 + k * 1024); } while (0)
#define PG8_LDB(dst, b, h) do { _Pragma("unroll") for (int n = 0; n < 2; ++n) _Pragma("unroll") for (int k = 0; k < 2; ++k) dst[n][k] = *(const PG8_LAS bf16x8*)(lds + PG8_SB(b, h) + boff + n * 2048 + k * 1024); } while (0)
#define PG8_MMA(ai, bj, At, Bt) do { __builtin_amdgcn_s_setprio(1); _Pragma("unroll") for (int m = 0; m < 4; ++m) _Pragma("unroll") for (int n = 0; n < 2; ++n) _Pragma("unroll") for (int k = 0; k < 2; ++k) \
        acc[ai][bj][m][n] = __builtin_amdgcn_mfma_f32_16x16x32_bf16(Bt[n][k], At[m][k], acc[ai][bj][m][n], 0, 0, 0); __builtin_amdgcn_s_setprio(0); } while (0)
#define PG8_WAIT_V(n) asm volatile("s_waitcnt vmcnt(" #n ")" ::: "memory")
#define PG8_WAIT_L(n) asm volatile("s_waitcnt lgkmcnt(" #n ")" ::: "memory")
#define PG8_BAR __builtin_amdgcn_s_barrier()
#define PG8_SCHED __builtin_amdgcn_sched_barrier(0)
    Unit cur, nxt; int ui = 0;
    if (!S.next(0, cur)) return;
    f32x4 acc[2][2][4][2];
#pragma unroll
    for (int a = 0; a < 2; ++a)
#pragma unroll
        for (int b = 0; b < 2; ++b)
#pragma unroll
            for (int m = 0; m < 4; ++m)
#pragma unroll
                for (int n = 0; n < 2; ++n) acc[a][b][m][n] = (f32x4){0.f, 0.f, 0.f, 0.f};
    bf16x8 At[4][2], B0[2][2], B1[2][2];
    const char* cA = (const char*)g.A + (size_t)cur.pm * tstep; const char* cB = (const char*)g.Bt + (size_t)cur.pn * tstep;
    S.a_ready(cur);
    if constexpr (SP2) {
        PG8_STAGE(PG8_SB(0, 0), cB, voffB); PG8_STAGE(PG8_SB(0, 1), cB + hstep, voffB); PG8_STAGE(PG8_SA(0, 0), cA, voffA); PG8_STAGE(PG8_SA(0, 1), cA + hstep, voffA);
        if (wr == 1) PG8_BAR;
        PG8_WAIT_V(2); PG8_BAR;
        PG8_STAGE(PG8_SB(1, 0), cB + kstep, voffB); PG8_STAGE(PG8_SA(1, 0), cA + kstep, voffA); PG8_STAGE(PG8_SB(1, 1), cB + hstep + kstep, voffB);
        PG8_WAIT_V(6); PG8_BAR;
    } else {
        PG8_STAGE(PG8_SB(0, 0), cB, voffB); PG8_STAGE(PG8_SA(0, 0), cA, voffA); PG8_STAGE(PG8_SB(0, 1), cB + hstep, voffB); PG8_STAGE(PG8_SA(0, 1), cA + hstep, voffA);
        if (wr == 1) PG8_BAR;
        PG8_WAIT_V(4); PG8_BAR;
        PG8_STAGE(PG8_SB(1, 0), cB + kstep, voffB); PG8_STAGE(PG8_SA(1, 0), cA + kstep, voffA); PG8_STAGE(PG8_SB(1, 1), cB + hstep + kstep, voffB);
        PG8_WAIT_V(6); PG8_BAR;
    }
    for (;;) {
        const bool has_next = S.next(ui + 1, nxt);
        const char* nA = has_next ? (const char*)g.A + (size_t)nxt.pm * tstep : cA; const char* nB = has_next ? (const char*)g.Bt + (size_t)nxt.pn * tstep : cB;
        for (int t = 0; t < nt; t += 2) {
            const bool last = (t == nt - 2);
            const char* a1 = cA + (size_t)(t + 1) * kstep;
            const char* a2 = last ? nA : cA + (size_t)(t + 2) * kstep; const char* b2 = last ? nB : cB + (size_t)(t + 2) * kstep;
            const char* a3 = a2 + kstep; const char* b3 = b2 + kstep;
            if (last && has_next) S.a_ready(nxt);
            if constexpr (SP2) {
            PG8_LDB(B0, 0, 0); PG8_LDB(B1, 0, 1); PG8_SCHED; PG8_LDA(At, 0, 0); PG8_STAGE(PG8_SA(1, 1), a1 + hstep, voffA);
            PG8_WAIT_V(8); PG8_WAIT_L(0); PG8_BAR; PG8_MMA(0, 0, At, B0); PG8_MMA(0, 1, At, B1); PG8_BAR; PG8_SCHED;
            PG8_LDA(At, 0, 1); PG8_STAGE(PG8_SB(0, 0), b2, voffB); PG8_STAGE(PG8_SB(0, 1), b2 + hstep, voffB); PG8_STAGE(PG8_SA(0, 0), a2, voffA);
            PG8_WAIT_V(8); PG8_WAIT_L(0); PG8_BAR; PG8_MMA(1, 0, At, B0); PG8_MMA(1, 1, At, B1); PG8_BAR; PG8_SCHED;
            PG8_LDB(B0, 1, 0); PG8_LDB(B1, 1, 1); PG8_SCHED; PG8_LDA(At, 1, 0); PG8_STAGE(PG8_SA(0, 1), a2 + hstep, voffA);
            PG8_WAIT_V(8); PG8_WAIT_L(0); PG8_BAR; PG8_MMA(0, 0, At, B0); PG8_MMA(0, 1, At, B1); PG8_BAR; PG8_SCHED;
            PG8_LDA(At, 1, 1); PG8_STAGE(PG8_SB(1, 0), b3, voffB); PG8_STAGE(PG8_SB(1, 1), b3 + hstep, voffB); PG8_STAGE(PG8_SA(1, 0), a3, voffA);
            PG8_WAIT_V(8); PG8_WAIT_L(0); PG8_BAR; PG8_MMA(1, 0, At, B0); PG8_MMA(1, 1, At, B1); PG8_BAR; PG8_SCHED;
            } else {
            PG8_LDB(B0, 0, 0); PG8_SCHED; PG8_LDA(At, 0, 0); PG8_STAGE(PG8_SA(1, 1), a1 + hstep, voffA);
            PG8_WAIT_L(8); PG8_BAR; PG8_WAIT_L(0); PG8_MMA(0, 0, At, B0); PG8_BAR; PG8_SCHED;
            PG8_LDB(B1, 0, 1); PG8_STAGE(PG8_SB(0, 0), b2, voffB);
            PG8_BAR; PG8_WAIT_L(0); PG8_MMA(0, 1, At, B1); PG8_BAR;
            PG8_LDA(At, 0, 1); PG8_STAGE(PG8_SA(0, 0), a2, voffA);
            PG8_BAR; PG8_WAIT_L(0); PG8_MMA(1, 0, At, B0); PG8_BAR; PG8_SCHED;
            PG8_STAGE(PG8_SB(0, 1), b2 + hstep, voffB);
            PG8_WAIT_V(6); PG8_BAR; PG8_MMA(1, 1, At, B1); PG8_BAR;
            PG8_LDB(B0, 1, 0); PG8_SCHED; PG8_LDA(At, 1, 0); PG8_STAGE(PG8_SA(0, 1), a2 + hstep, voffA);
            PG8_WAIT_L(8); PG8_BAR; PG8_WAIT_L(0); PG8_MMA(0, 0, At, B0); PG8_BAR; PG8_SCHED;
            PG8_LDB(B1, 1, 1); PG8_STAGE(PG8_SB(1, 0), b3, voffB);
            PG8_BAR; PG8_WAIT_L(0); PG8_MMA(0, 1, At, B1); PG8_BAR;
            PG8_LDA(At, 1, 1); PG8_STAGE(PG8_SA(1, 0), a3, voffA);
            PG8_BAR; PG8_WAIT_L(0); PG8_MMA(1, 0, At, B0); PG8_BAR; PG8_SCHED;
            PG8_STAGE(PG8_SB(1, 1), b3 + hstep, voffB);
            PG8_WAIT_V(6); PG8_BAR; PG8_MMA(1, 1, At, B1); PG8_BAR;
            }
        }
        if constexpr (ALIGN_EPI) { if (wr == 0) PG8_BAR; }
        if constexpr (!Epi::AFTER_DRAIN) { E(acc, cur, wr, wc, fr, fq); S.done(cur); }
        if (!has_next) break;
#pragma unroll
        for (int a = 0; a < 2; ++a)
#pragma unroll
            for (int b = 0; b < 2; ++b)
#pragma unroll
                for (int m = 0; m < 4; ++m)
#pragma unroll
                    for (int n = 0; n < 2; ++n) acc[a][b][m][n] = (f32x4){0.f, 0.f, 0.f, 0.f};
        cur = nxt; cA = nA; cB = nB; ++ui;
        if constexpr (ALIGN_EPI) { if (wr == 1) PG8_BAR; }
    }
    PG8_WAIT_V(0);
    if constexpr (!ALIGN_EPI) { if (wr == 0) PG8_BAR; }
    PG8_BAR;
    if constexpr (Epi::AFTER_DRAIN) { E.fused(acc, cur, wr, wc, fr, fq, lds, wid, lane); S.done(cur); }
#undef PG8_SA
#undef PG8_SB
#undef PG8_STAGE
#undef PG8_LDA
#undef PG8_LDB
#undef PG8_MMA
#undef PG8_WAIT_V
#undef PG8_WAIT_L
#undef PG8_BAR
#undef PG8_SCHED
}
}
#define GAS __attribute__((address_space(1)))
#define LAS __attribute__((address_space(3)))
typedef unsigned short bf16;
typedef unsigned v4u __attribute__((ext_vector_type(4)));
typedef float f32x4 __attribute__((ext_vector_type(4)));
typedef short bf16x8 __attribute__((ext_vector_type(8)));
typedef GAS unsigned gu32;
typedef GAS unsigned long long gu64;
#define RLX_AGENT __ATOMIC_RELAXED, __HIP_MEMORY_SCOPE_AGENT
#define LDS_WAIT() asm volatile("s_waitcnt lgkmcnt(0)" ::: "memory")
#define VM_WAIT() asm volatile("s_waitcnt vmcnt(0)" ::: "memory")
__device__ __forceinline__ unsigned long long rt() { return __builtin_amdgcn_s_memrealtime(); }
__device__ __forceinline__ unsigned f2bf(float f) { unsigned u = __builtin_bit_cast(unsigned, f); return (u + 0x7fffu + ((u >> 16) & 1u)) >> 16; }
__device__ __forceinline__ unsigned pk2(float lo, float hi) { return f2bf(lo) | (f2bf(hi) << 16); }

#define XB_TMO      128
#define XB_XCNT(j)  (256  + 64 * (j))
#define XB_XSUB(j)  (1280 + 64 * (j))
#define XB_XGEN(j)  (2304 + 64 * (j))
#define XB_TOP      3328
#define XB_TOPGEN   3392
#define XCD_BAR_WORDS 3456
#define XB_SPIN_CAP (1u << 18)

__device__ __forceinline__ unsigned xb_ld(unsigned* p)              { return __hip_atomic_load(p, __ATOMIC_RELAXED, __HIP_MEMORY_SCOPE_AGENT); }
__device__ __forceinline__ unsigned xb_add(unsigned* p, unsigned v) { return __hip_atomic_fetch_add(p, v, __ATOMIC_RELAXED, __HIP_MEMORY_SCOPE_AGENT); }
__device__ __forceinline__ unsigned xb_xcc_id() { return (unsigned)__builtin_amdgcn_s_getreg((3 << 11) | 20) & 0xFu; }
#define XB_SPIN(cond, bar) do { unsigned _sp = 0; while (cond) { __builtin_amdgcn_s_sleep(1); \
    if ((++_sp & 255u) == 0u) { if (xb_ld(&(bar)[XB_TMO])) break; if (_sp > XB_SPIN_CAP) { atomicAdd(&(bar)[XB_TMO], 1u); break; } } } } while (0)

struct XcdBarrier {
    unsigned* bar; unsigned x;
    volatile LAS unsigned* st;
};

__device__ __forceinline__ XcdBarrier xcd_barrier_post(unsigned* bar, volatile LAS unsigned* st) {
    XcdBarrier b; b.bar = bar; b.x = xb_xcc_id(); b.st = st;
    if (threadIdx.x == 0) (void)xb_add(&bar[XB_XCNT(b.x)], 1u);
    return b;
}
__device__ __forceinline__ void xcd_barrier_complete(unsigned* bar, unsigned x, unsigned& nloc, unsigned& nx) {
    const unsigned G = gridDim.x * gridDim.y * gridDim.z;
    unsigned sum, cnt, mine, sp = 0u;
    for (;;) {
        sum = 0u; cnt = 0u; mine = 0u;
#pragma unroll
        for (unsigned j = 0; j < 16; ++j) { const unsigned c = xb_ld(&bar[XB_XCNT(j)]); sum += c; cnt += (c > 0u) ? 1u : 0u; mine = (j == x) ? c : mine; }
        if (sum == G) break;
        __builtin_amdgcn_s_sleep(1);
        if ((++sp & 255u) == 0u) { if (xb_ld(&bar[XB_TMO])) break; if (sp > XB_SPIN_CAP) { atomicAdd(&bar[XB_TMO], 1u); break; } }
    }
    nloc = mine > 0u ? mine : 1u; nx = cnt > 0u ? cnt : 1u;
}

__device__ __forceinline__ void xcd_barrier(const XcdBarrier& b) {
    asm volatile("s_waitcnt vmcnt(0)" ::: "memory");
    __syncthreads();
    if (threadIdx.x == 0) {
        unsigned* bar = b.bar;
        __builtin_amdgcn_s_waitcnt(0);
        unsigned nloc = b.st[0], nx = b.st[1];
        if (nloc == 0u) { xcd_barrier_complete(bar, b.x, nloc, nx); b.st[0] = nloc; b.st[1] = nx; }
        const unsigned old = xb_add(&bar[XB_XSUB(b.x)], 1u);
        const unsigned gen = old / nloc;
        if (old + 1u == (gen + 1u) * nloc) {
            __builtin_amdgcn_fence(__ATOMIC_RELEASE, "agent");
            asm volatile("s_waitcnt vmcnt(0)" ::: "memory");
            const unsigned og = xb_add(&bar[XB_TOP], 1u);
            const unsigned tg = og / nx;
            if (og + 1u == (tg + 1u) * nx) xb_add(&bar[XB_TOPGEN], 1u);
            else XB_SPIN(xb_ld(&bar[XB_TOPGEN]) == tg, bar);
            __builtin_amdgcn_fence(__ATOMIC_ACQUIRE, "agent");
            xb_add(&bar[XB_XGEN(b.x)], 1u);
            asm volatile("s_waitcnt vmcnt(0)" ::: "memory");
        } else {
            XB_SPIN(xb_ld(&bar[XB_XGEN(b.x)]) == gen, bar);
            __builtin_amdgcn_fence(__ATOMIC_ACQUIRE, "agent");
            asm volatile("s_waitcnt vmcnt(0)" ::: "memory");
        }
    }
    __syncthreads();
}
constexpr int NWAVES = 8, NTHREADS = 512;
constexpr int DM = 1024, SEQ = 4096, NB = 4, MP = NB * SEQ, SB = 32, ST = 4, MS = SB * ST, MREAL = MP + MS, MROWS = 16640;
constexpr int DFF = 2816, NIN = 2 * DFF, QW = 4608, AW = 512, DV = 3072, UVW = 6144;
constexpr float RMS_EPS = 1e-6f, LN_EPS = 1e-5f;
constexpr size_t O_Y = 0, O_YS = 16777216, O_KV128P = 16908288, O_KV512P = 17956864, O_KV2048P = 22151168, O_KV128S = 38928384, O_KV512S = 39190528, O_KV2048S = 39452672, O_VC = 39714816, O_END = 40501248;
constexpr size_t MiB = 1u << 20;
constexpr size_t WS_CTL = 0, CTL_ZERO_BYTES = 1 * MiB;
constexpr size_t SZ_WIN = (size_t)NIN * DM * 2, SZ_WOUT = (size_t)DM * DFF * 2, SZ_WQKV = (size_t)QW * DM * 2, SZ_WOA = (size_t)DM * AW * 2, SZ_WUV = (size_t)UVW * DM * 2, SZ_WOB = (size_t)DM * DV * 2;
constexpr size_t WS_WIN1 = 1 * MiB, WS_WOUT1 = WS_WIN1 + 4 * SZ_WIN, WS_WIN2 = WS_WOUT1 + 4 * SZ_WOUT, WS_WOUT2 = WS_WIN2 + 4 * SZ_WIN;
constexpr size_t WS_WQKV = WS_WOUT2 + 4 * SZ_WOUT, WS_WOA = WS_WQKV + 2 * SZ_WQKV, WS_WUV = WS_WOA + 2 * SZ_WOA, WS_WOB = WS_WUV + 2 * SZ_WUV;
constexpr size_t WS_X = WS_WOB + 2 * SZ_WOB;
constexpr size_t WS_XB = WS_X + (size_t)MROWS * DM * 4;
constexpr size_t WS_SS = WS_XB + (size_t)MROWS * DM * 2;
constexpr size_t WS_BIG = WS_SS + (size_t)MROWS * 16 * 4;
constexpr size_t WS_YZ = WS_BIG + (size_t)MROWS * UVW * 2;
constexpr size_t WS_END = WS_YZ + (size_t)MROWS * DV * 2;
static_assert(WS_WIN1 % 256 == 0 && WS_X % 256 == 0 && WS_XB % 256 == 0 && WS_SS % 256 == 0 && WS_BIG % 256 == 0 && WS_YZ % 256 == 0, "alignment");
constexpr int CW_TMO = 0, CW_BAR = 4096;
constexpr int RING_OFF = 0, RING_BYTES = 131072;
constexpr int LDSCTL_OFF = RING_BYTES, MISC_OFF = LDSCTL_OFF + 320;
constexpr int LDS_BYTES = 147456;
struct Args { const float* in[21]; float* out; unsigned char* ws; int ph_lo, ph_hi; };
#define LOCAL_IDS int tid_ = threadIdx.x; asm volatile("" : "+v"(tid_)); const int tid = tid_, lane = tid & 63, wave = __builtin_amdgcn_readfirstlane(tid >> 6); (void)tid; (void)lane; (void)wave
struct Frame {
    LAS unsigned char* lds; volatile LAS unsigned* MISC; gu32* ctl;
    int vcu, G;
};
__device__ __forceinline__ float wave_sum(float v) {
#pragma unroll
    for (int o = 1; o < 64; o <<= 1) v += __shfl_xor(v, o);
    return v;
}
__device__ __forceinline__ float wave_max(float v) {
#pragma unroll
    for (int o = 1; o < 64; o <<= 1) v = fmaxf(v, __shfl_xor(v, o));
    return v;
}
__device__ __forceinline__ float bf2f(unsigned short h) { return __builtin_bit_cast(float, (unsigned)h << 16); }
__device__ __forceinline__ float bflo(unsigned w) { return __builtin_bit_cast(float, w << 16); }
__device__ __forceinline__ float bfhi(unsigned w) { return __builtin_bit_cast(float, w & 0xffff0000u); }

__device__ __forceinline__ void p0_transpose_item(const float* W, int K, int N, const float* gk, bf16* WT, int mode, LAS float* scr, int item, int lane) {
    const int nblk = N / 32, kb = item / nblk, nb = item % nblk, k0 = 64 * kb, n0 = 32 * nb;
#pragma unroll 8
    for (int i = 0; i < 32; ++i) { const int kk = 2 * i + (lane >> 5); const float gsc = gk ? gk[k0 + kk] : 1.0f; scr[kk * 33 + (lane & 31)] = gsc * W[(size_t)(k0 + kk) * N + n0 + (lane & 31)]; }
    LDS_WAIT(); asm volatile("" ::: "memory");
    int r0 = n0;
    if (mode == 1) { const int up = n0 >= DFF ? 1 : 0, j = n0 - up * DFF; r0 = 256 * (j >> 7) + 128 * up + (j & 127); }
    const int c = lane & 7;
#pragma unroll
    for (int j = 0; j < 4; ++j) { const int n = (lane >> 3) + 8 * j; const LAS float* s = scr + (8 * c) * 33 + n;
        v4u o; o.x = pk2(s[0 * 33], s[1 * 33]); o.y = pk2(s[2 * 33], s[3 * 33]); o.z = pk2(s[4 * 33], s[5 * 33]); o.w = pk2(s[6 * 33], s[7 * 33]);
        *(GAS v4u*)(WT + (size_t)(r0 + n) * K + k0 + 8 * c) = o; }
    LDS_WAIT(); asm volatile("" ::: "memory");
}
__device__ __forceinline__ void p0_prologue(Frame& F, const Args& a) {
    LOCAL_IDS;
    LAS float* scr = (LAS float*)(F.lds + RING_OFF + wave * 16384);
    const int gw = F.vcu * NWAVES + wave, NGW = F.G * NWAVES;
    unsigned char* ws = a.ws;
    constexpr int I_IN = 16 * 176, I_OUT = 44 * 32, I_QKV = 16 * 144, I_OA = 8 * 32, I_UV = 16 * 192, I_OB = 48 * 32;
    constexpr int NITEMS = 8 * I_IN + 8 * I_OUT + 2 * (I_QKV + I_OA + I_UV + I_OB);
    for (int it = gw; it < NITEMS; it += NGW) {
        int r = it;
        if (r < 4 * I_IN) { const int i = r / I_IN; p0_transpose_item(a.in[6] + (size_t)i * DM * NIN, DM, NIN, a.in[5] + i * DM, (bf16*)(ws + WS_WIN1 + i * SZ_WIN), 1, scr, r % I_IN, lane); continue; } r -= 4 * I_IN;
        if (r < 4 * I_OUT) { const int i = r / I_OUT; p0_transpose_item(a.in[7] + (size_t)i * DFF * DM, DFF, DM, nullptr, (bf16*)(ws + WS_WOUT1 + i * SZ_WOUT), 0, scr, r % I_OUT, lane); continue; } r -= 4 * I_OUT;
        if (r < 4 * I_IN) { const int i = r / I_IN; p0_transpose_item(a.in[10] + (size_t)i * DM * NIN, DM, NIN, a.in[9] + i * DM, (bf16*)(ws + WS_WIN2 + i * SZ_WIN), 1, scr, r % I_IN, lane); continue; } r -= 4 * I_IN;
        if (r < 4 * I_OUT) { const int i = r / I_OUT; p0_transpose_item(a.in[11] + (size_t)i * DFF * DM, DFF, DM, nullptr, (bf16*)(ws + WS_WOUT2 + i * SZ_WOUT), 0, scr, r % I_OUT, lane); continue; } r -= 4 * I_OUT;
        if (r < 2 * I_QKV) { const int l = r / I_QKV; p0_transpose_item(a.in[12] + (size_t)l * DM * QW, DM, QW, a.in[8] + (2 * l) * DM, (bf16*)(ws + WS_WQKV + l * SZ_WQKV), 0, scr, r % I_QKV, lane); continue; } r -= 2 * I_QKV;
        if (r < 2 * I_OA) { const int l = r / I_OA; p0_transpose_item(a.in[13] + (size_t)l * AW * DM, AW, DM, nullptr, (bf16*)(ws + WS_WOA + l * SZ_WOA), 0, scr, r % I_OA, lane); continue; } r -= 2 * I_OA;
        if (r < 2 * I_UV) { const int l = r / I_UV; p0_transpose_item(a.in[14] + (size_t)l * DM * UVW, DM, UVW, a.in[8] + (2 * l + 1) * DM, (bf16*)(ws + WS_WUV + l * SZ_WUV), 0, scr, r % I_UV, lane); continue; } r -= 2 * I_UV;
        { const int l = r / I_OB; p0_transpose_item(a.in[19] + (size_t)l * DV * DM, DV, DM, nullptr, (bf16*)(ws + WS_WOB + l * SZ_WOB), 0, scr, r % I_OB, lane); }
    }
    float* X = (float*)(ws + WS_X); bf16* XB = (bf16*)(ws + WS_XB); float* SS = (float*)(ws + WS_SS);
    bf16* YZ = (bf16*)(ws + WS_YZ);
    for (int m = gw; m < MROWS; m += NGW) {
        const float* src = m < MP ? a.in[0] + (size_t)m * DM : (m < MREAL ? a.in[1] + (size_t)(m - MP) * DM : nullptr);
        f32x4 v[4]; float s = 0.f;
#pragma unroll
        for (int j = 0; j < 4; ++j) { v[j] = src ? ((const GAS f32x4*)src)[lane + 64 * j] : (f32x4){0.f, 0.f, 0.f, 0.f}; s += (v[j].x * v[j].x + v[j].y * v[j].y) + (v[j].z * v[j].z + v[j].w * v[j].w); }
        s = wave_sum(s);
#pragma unroll
        for (int j = 0; j < 4; ++j) { ((GAS f32x4*)(X + (size_t)m * DM))[lane + 64 * j] = v[j];
            ((GAS unsigned long long*)(XB + (size_t)m * DM))[lane + 64 * j] = (unsigned long long)pk2(v[j].x, v[j].y) | ((unsigned long long)pk2(v[j].z, v[j].w) << 32); }
        if (lane < 16) SS[(size_t)m * 16 + lane] = lane == 0 ? s : 0.f;
        if (m >= MREAL) { for (int j = lane; j < DV / 8; j += 64) ((GAS v4u*)(YZ + (size_t)m * DV))[j] = (v4u){0u, 0u, 0u, 0u}; }
    }
}

__device__ __forceinline__ float dot64_bf16(const unsigned (&q)[32], const bf16* kp) {
    float s = 0.f;
#pragma unroll
    for (int c = 0; c < 8; ++c) { const v4u kx = *(const GAS v4u*)(kp + 8 * c);
        s += bflo(q[4 * c + 0]) * bflo(kx.x) + bfhi(q[4 * c + 0]) * bfhi(kx.x); s += bflo(q[4 * c + 1]) * bflo(kx.y) + bfhi(q[4 * c + 1]) * bfhi(kx.y);
        s += bflo(q[4 * c + 2]) * bflo(kx.z) + bfhi(q[4 * c + 2]) * bfhi(kx.z); s += bflo(q[4 * c + 3]) * bflo(kx.w) + bfhi(q[4 * c + 3]) * bfhi(kx.w); }
    return s;
}
__device__ __forceinline__ float dot64_f32(const unsigned (&q)[32], const float* kp) {
    float s = 0.f;
#pragma unroll
    for (int c = 0; c < 16; ++c) { const f32x4 kx = *(const GAS f32x4*)(kp + 4 * c);
        s += bflo(q[2 * c]) * kx.x + bfhi(q[2 * c]) * kx.y; s += bflo(q[2 * c + 1]) * kx.z + bfhi(q[2 * c + 1]) * kx.w; }
    return s;
}
__device__ __forceinline__ void load_q(unsigned (&q)[32], const bf16* qp) {
#pragma unroll
    for (int c = 0; c < 8; ++c) { const v4u x = *(const GAS v4u*)(qp + 8 * c); q[4 * c] = x.x; q[4 * c + 1] = x.y; q[4 * c + 2] = x.z; q[4 * c + 3] = x.w; }
}
__device__ __forceinline__ void attn_prompt_v1(Frame& F, const bf16* QKV, bf16* Y) {
    LOCAL_IDS;
    const float NEG = -INFINITY;
    for (int it = F.vcu; it < 256 * 8; it += F.G) {
        const int rb = it >> 3, h = it & 7;
        for (int i = 0; i < 8; ++i) {
            const int r = rb * 64 + wave * 8 + i, t = r & (SEQ - 1);
            float og[3], lse[3];
#pragma unroll
            for (int g = 0; g < 3; ++g) {
                const int sh = 2 * g, m = t >> sh, nk = (m < 128 ? m : 128) + 1;
                const int qcol = g * 512 + h * 64;
                unsigned q[32]; load_q(q, QKV + (size_t)r * QW + qcol);
                const bf16* kb = QKV + (size_t)r * QW + 1536 + qcol; const bf16* vb = QKV + (size_t)r * QW + 3072 + qcol;
                const size_t jstride = (size_t)QW << sh;
                float s0 = NEG, s1 = NEG, s2 = NEG;
                if (lane < nk) s0 = 0.125f * dot64_bf16(q, kb - (size_t)lane * jstride);
                if (lane + 64 < nk) s1 = 0.125f * dot64_bf16(q, kb - (size_t)(lane + 64) * jstride);
                if (nk > 128) { if (lane == 0) s2 = 0.125f * dot64_bf16(q, kb - (size_t)128 * jstride); }
                const float mx = wave_max(fmaxf(fmaxf(s0, s1), s2));
                const float p0 = __expf(s0 - mx), p1 = __expf(s1 - mx), p2 = __expf(s2 - mx);
                const float l = wave_sum(p0 + p1 + p2);
                float o = 0.f;
                const int n0 = nk < 64 ? nk : 64;
                for (int j = 0; j < n0; ++j) o += __shfl(p0, j) * bf2f(vb[lane - (ptrdiff_t)((size_t)j * jstride)]);
                const int n1 = nk - 64 < 64 ? nk - 64 : 64;
                for (int j = 0; j < n1; ++j) o += __shfl(p1, j) * bf2f(vb[lane - (ptrdiff_t)((size_t)(j + 64) * jstride)]);
                if (nk > 128) o += __shfl(p2, 0) * bf2f(vb[lane - (ptrdiff_t)((size_t)128 * jstride)]);
                og[g] = o / l; lse[g] = mx + __logf(l);
            }
            const float M = fmaxf(fmaxf(lse[0], lse[1]), lse[2]);
            const float w0 = __expf(lse[0] - M), w1 = __expf(lse[1] - M), w2 = __expf(lse[2] - M);
            const float y = (w0 * og[0] + w1 * og[1] + w2 * og[2]) / (w0 + w1 + w2);
            Y[(size_t)r * AW + h * 64 + lane] = (bf16)f2bf(y);
        }
    }
}
__device__ __forceinline__ void attn_sample_v1(Frame& F, const Args& a, const bf16* QKV, bf16* Y, int li) {
    LOCAL_IDS;
    const int gw = F.vcu * NWAVES + wave, NGW = F.G * NWAVES;
    for (int task = gw; task < MS * 8; task += NGW) {
        const int sr = task >> 3, h = task & 7, sb = sr >> 2, t = sr & 3, r = MP + sr;
        float og[3], lse[3];
#pragma unroll
        for (int g = 0; g < 3; ++g) {
            const int sh = 2 * g, dil = 1 << sh, L = 128 << sh;
            const float* cache = a.in[2 + g] + ((size_t)(li * SB + sb) * L) * 1024;
            const int qcol = g * 512 + h * 64;
            unsigned q[32]; load_q(q, QKV + (size_t)r * QW + qcol);
            float s[3];
#pragma unroll
            for (int rd = 0; rd < 3; ++rd) { const int j = lane + 64 * rd; s[rd] = -INFINITY;
                if (j <= 128) { const int idx = L + t - dil * j;
                    if (idx >= L) s[rd] = 0.125f * dot64_bf16(q, QKV + (size_t)(MP + sb * 4 + (idx - L)) * QW + 1536 + qcol);
                    else s[rd] = 0.125f * dot64_f32(q, cache + (size_t)idx * 1024 + h * 64); } }
            const float mx = wave_max(fmaxf(fmaxf(s[0], s[1]), s[2]));
            const float p0 = __expf(s[0] - mx), p1 = __expf(s[1] - mx), p2 = __expf(s[2] - mx);
            const float l = wave_sum(p0 + p1 + p2);
            float o = 0.f;
            for (int j = 0; j <= 128; ++j) { const float pj = j < 64 ? __shfl(p0, j) : (j < 128 ? __shfl(p1, j - 64) : __shfl(p2, 0));
                const int idx = L + t - dil * j;
                const float v = idx >= L ? bf2f(QKV[(size_t)(MP + sb * 4 + (idx - L)) * QW + 3072 + qcol + lane]) : cache[(size_t)idx * 1024 + 512 + h * 64 + lane];
                o += pj * v; }
            og[g] = o / l; lse[g] = mx + __logf(l);
        }
        const float M = fmaxf(fmaxf(lse[0], lse[1]), lse[2]);
        const float w0 = __expf(lse[0] - M), w1 = __expf(lse[1] - M), w2 = __expf(lse[2] - M);
        const float y = (w0 * og[0] + w1 * og[1] + w2 * og[2]) / (w0 + w1 + w2);
        Y[(size_t)r * AW + h * 64 + lane] = (bf16)f2bf(y);
    }
}

__device__ __forceinline__ void row_stats_bf16(const bf16* vp, int lane, float& mean, float& rstd) {
    float s = 0.f, q = 0.f;
#pragma unroll
    for (int j = 0; j < 6; ++j) { const v4u x = ((const GAS v4u*)vp)[lane + 64 * j]; const unsigned w[4] = {x.x, x.y, x.z, x.w};
#pragma unroll
        for (int e = 0; e < 4; ++e) { const float a = bflo(w[e]), b = bfhi(w[e]); s += a + b; q += a * a + b * b; } }
    s = wave_sum(s); q = wave_sum(q);
    mean = s * (1.0f / DV); const float var = q * (1.0f / DV) - mean * mean; rstd = __builtin_amdgcn_rsqf(fmaxf(var, 0.f) + LN_EPS);
}
__device__ __forceinline__ void spatial_prompt_v1(Frame& F, const Args& a, const bf16* UV, bf16* Z, int li) {
    LOCAL_IDS;
    LAS float* Wl = (LAS float*)(F.lds + RING_OFF);
    LAS float* st = (LAS float*)(F.lds + RING_OFF + 65536);
    const float* lng = a.in[15] + li * DV; const float* lnb = a.in[16] + li * DV;
    for (int it = F.vcu; it < 128 * 8; it += F.G) {
        const int cidx = it >> 3, gg = it & 7, row0 = cidx * 128;
        const float* wsp = a.in[17] + (size_t)(li * 8 + gg) * 128 * 128; const float* bsp = a.in[18] + (li * 8 + gg) * 128;
        __syncthreads();
        for (int i = 0; i < 16; ++i) { const int rr = wave * 16 + i; float mean, rstd; row_stats_bf16(UV + (size_t)(row0 + rr) * UVW + DV, lane, mean, rstd);
            if (lane == 0) { st[2 * rr] = mean; st[2 * rr + 1] = rstd; } }
        for (int e = tid; e < 128 * 128; e += NTHREADS) { const int t = e >> 7, s = e & 127; Wl[s * 128 + t] = s <= t ? wsp[e] : 0.f; }
        __syncthreads();
        if (tid < 384) {
            const int ch = gg * 384 + tid; const float gain = lng[ch], bias = lnb[ch];
            float acc[128];
#pragma unroll
            for (int t = 0; t < 128; ++t) acc[t] = 0.f;
#pragma unroll 1
            for (int s = 0; s < 128; ++s) {
                const float vn = (bf2f(UV[(size_t)(row0 + s) * UVW + DV + ch]) - st[2 * s]) * st[2 * s + 1] * gain + bias;
#pragma unroll
                for (int t4 = 0; t4 < 32; ++t4) { const f32x4 w = *(const LAS f32x4*)(Wl + s * 128 + 4 * t4);
                    acc[4 * t4] += w.x * vn; acc[4 * t4 + 1] += w.y * vn; acc[4 * t4 + 2] += w.z * vn; acc[4 * t4 + 3] += w.w * vn; }
            }
#pragma unroll
            for (int t = 0; t < 128; ++t) { const float mixed = acc[t] + bsp[t]; const float u = bf2f(UV[(size_t)(row0 + t) * UVW + ch]);
                Z[(size_t)(row0 + t) * DV + ch] = (bf16)f2bf(u * mixed); }
        }
    }
}
__device__ __forceinline__ void spatial_sample_v1(Frame& F, const Args& a, const bf16* UV, bf16* Z, int li) {
    LOCAL_IDS;
    LAS float* st = (LAS float*)(F.lds + RING_OFF + 65536 + 2048);
    const float* lng = a.in[15] + li * DV; const float* lnb = a.in[16] + li * DV;
    for (int sb = F.vcu; sb < SB; sb += F.G) {
        const int row0 = MP + sb * 4;
        __syncthreads();
        if (wave < 4) { float mean, rstd; row_stats_bf16(UV + (size_t)(row0 + wave) * UVW + DV, lane, mean, rstd); if (lane == 0) { st[2 * wave] = mean; st[2 * wave + 1] = rstd; } }
        __syncthreads();
        for (int ch = tid; ch < DV; ch += NTHREADS) {
            const int g = ch / 384; const float gain = lng[ch], bias = lnb[ch];
            const float* wsp = a.in[17] + (size_t)(li * 8 + g) * 128 * 128; const float* bsp = a.in[18] + (li * 8 + g) * 128;
            float vn[4];
#pragma unroll
            for (int t = 0; t < 4; ++t) { vn[t] = (bf2f(UV[(size_t)(row0 + t) * UVW + DV + ch]) - st[2 * t]) * st[2 * t + 1] * gain + bias;
                a.out[O_VC + ((size_t)(li * SB + sb) * 4 + t) * DV + ch] = vn[t]; }
#pragma unroll
            for (int t = 0; t < 4; ++t) { float mixed = bsp[t];
#pragma unroll
                for (int s = 0; s < 4; ++s) if (s <= t) mixed += wsp[t * 128 + s] * vn[s];
                Z[(size_t)(row0 + t) * DV + ch] = (bf16)f2bf(bf2f(UV[(size_t)(row0 + t) * UVW + ch]) * mixed); }
        }
    }
}
__device__ __forceinline__ void final_norm(Frame& F, const Args& a) {
    LOCAL_IDS;
    const int gw = F.vcu * NWAVES + wave, NGW = F.G * NWAVES;
    const float* X = (const float*)(a.ws + WS_X); const float* SS = (const float*)(a.ws + WS_SS); const float* gf = a.in[20];
    for (int m = gw; m < MREAL; m += NGW) {
        const float rs = pg8::row_rstd(SS, m);
        float* dst = m < MP ? a.out + O_Y + (size_t)m * DM : a.out + O_YS + (size_t)(m - MP) * DM;
#pragma unroll
        for (int j = 0; j < 4; ++j) { const f32x4 x = ((const GAS f32x4*)(X + (size_t)m * DM))[lane + 64 * j]; const f32x4 g = ((const GAS f32x4*)gf)[lane + 64 * j];
            ((GAS f32x4*)dst)[lane + 64 * j] = x * rs * g; }
    }
}
constexpr int NPH = 30;
#ifndef MK_N_LAUNCHES
#define MK_N_LAUNCHES 30
#endif
__global__ void __launch_bounds__(NTHREADS, 2) fwd(Args args) {
    extern __shared__ __attribute__((aligned(16))) unsigned char lds[];
    Frame F;
    F.lds = (LAS unsigned char*)lds;
    F.MISC = (volatile LAS unsigned*)(F.lds + MISC_OFF);
    F.G = gridDim.x; { const int bx = blockIdx.x; F.vcu = (F.G % 8 == 0) ? (bx % 8) * (F.G / 8) + bx / 8 : bx; }
    unsigned char* ws = args.ws;
    F.ctl = (gu32*)(ws + WS_CTL);
    for (int u = threadIdx.x; u < (LDS_BYTES - LDSCTL_OFF) / 4; u += NTHREADS) ((LAS unsigned*)(F.lds + LDSCTL_OFF))[u] = 0u;
    __syncthreads();
    XcdBarrier bar; bar.bar = (unsigned*)(F.ctl + CW_BAR); bar.x = 0; bar.st = nullptr;
    if (MK_N_LAUNCHES == 1) bar = xcd_barrier_post((unsigned*)(F.ctl + CW_BAR), F.MISC + 8);
    const int lo = args.ph_lo, hi = args.ph_hi;
#define IN(k) (lo <= (k) && (k) < hi)
#define SEAM(k) do { if (IN((k) + 1)) xcd_barrier(bar); } while (0)
    float* X = (float*)(ws + WS_X); bf16* XB = (bf16*)(ws + WS_XB); float* SS = (float*)(ws + WS_SS);
    bf16* BIG = (bf16*)(ws + WS_BIG); bf16* YZ = (bf16*)(ws + WS_YZ);

    if (IN(0)) { p0_prologue(F, args); SEAM(0); }
    for (int L = 0; L < 4; ++L) {
        const int pb = 1 + 7 * L, li = L >> 1;
        if (IN(pb + 0)) {
            pg8::Gemm g{XB, (const bf16*)(ws + WS_WIN1 + L * SZ_WIN), MROWS, NIN, DM}; pg8::StaticOrder S; S.init(MROWS, NIN, F.G, (int)blockIdx.x);
            pg8::EpiSwiglu E{BIG, SS, DFF};
            pg8::gemm_phase<pg8::EpiSwiglu, pg8::StaticOrder, true, true>(F.lds + RING_OFF, g, S, E);
            SEAM(pb + 0);
        }
        if (IN(pb + 1)) {
            pg8::Gemm g{BIG, (const bf16*)(ws + WS_WOUT1 + L * SZ_WOUT), MROWS, DM, DFF}; pg8::StaticOrder S; S.init(MROWS, DM, F.G, (int)blockIdx.x);
            pg8::EpiResid E{X, XB, SS, 0.5f};
            pg8::gemm_phase<pg8::EpiResid, pg8::StaticOrder, true, true>(F.lds + RING_OFF, g, S, E);
            SEAM(pb + 1);
        }
        if ((L & 1) == 0) {
            if (IN(pb + 2)) {
                pg8::Gemm g{XB, (const bf16*)(ws + WS_WQKV + li * SZ_WQKV), MROWS, QW, DM}; pg8::StaticOrder S; S.init(MROWS, QW, F.G, (int)blockIdx.x);
                pg8::EpiQkv E{BIG, SS, args.out, li};
                pg8::gemm_phase<pg8::EpiQkv, pg8::StaticOrder, true, true>(F.lds + RING_OFF, g, S, E);
                SEAM(pb + 2);
            }
            if (IN(pb + 3)) { attn_prompt_v1(F, BIG, YZ); attn_sample_v1(F, args, BIG, YZ, li); SEAM(pb + 3); }
            if (IN(pb + 4)) {
                pg8::Gemm g{YZ, (const bf16*)(ws + WS_WOA + li * SZ_WOA), MROWS, DM, AW}; pg8::StaticOrder S; S.init(MROWS, DM, F.G, (int)blockIdx.x);
                pg8::EpiResid E{X, XB, SS, 1.0f};
                pg8::gemm_phase<pg8::EpiResid, pg8::StaticOrder, true, true>(F.lds + RING_OFF, g, S, E);
                SEAM(pb + 4);
            }
        } else {
            if (IN(pb + 2)) {
                pg8::Gemm g{XB, (const bf16*)(ws + WS_WUV + li * SZ_WUV), MROWS, UVW, DM}; pg8::StaticOrder S; S.init(MROWS, UVW, F.G, (int)blockIdx.x);
                pg8::EpiUv E{BIG, SS};
                pg8::gemm_phase<pg8::EpiUv, pg8::StaticOrder, true, true>(F.lds + RING_OFF, g, S, E);
                SEAM(pb + 2);
            }
            if (IN(pb + 3)) { spatial_prompt_v1(F, args, BIG, YZ, li); spatial_sample_v1(F, args, BIG, YZ, li); SEAM(pb + 3); }
            if (IN(pb + 4)) {
                pg8::Gemm g{YZ, (const bf16*)(ws + WS_WOB + li * SZ_WOB), MROWS, DM, DV}; pg8::StaticOrder S; S.init(MROWS, DM, F.G, (int)blockIdx.x);
                pg8::EpiResid E{X, XB, SS, 1.0f};
                pg8::gemm_phase<pg8::EpiResid, pg8::StaticOrder, true, true>(F.lds + RING_OFF, g, S, E);
                SEAM(pb + 4);
            }
        }
        if (IN(pb + 5)) {
            pg8::Gemm g{XB, (const bf16*)(ws + WS_WIN2 + L * SZ_WIN), MROWS, NIN, DM}; pg8::StaticOrder S; S.init(MROWS, NIN, F.G, (int)blockIdx.x);
            pg8::EpiSwiglu E{BIG, SS, DFF};
            pg8::gemm_phase<pg8::EpiSwiglu, pg8::StaticOrder, true, true>(F.lds + RING_OFF, g, S, E);
            SEAM(pb + 5);
        }
        if (IN(pb + 6)) {
            pg8::Gemm g{BIG, (const bf16*)(ws + WS_WOUT2 + L * SZ_WOUT), MROWS, DM, DFF}; pg8::StaticOrder S; S.init(MROWS, DM, F.G, (int)blockIdx.x);
            pg8::EpiResid E{X, XB, SS, 0.5f};
            pg8::gemm_phase<pg8::EpiResid, pg8::StaticOrder, true, true>(F.lds + RING_OFF, g, S, E);
            SEAM(pb + 6);
        }
    }
    if (IN(29)) final_norm(F, args);
#undef IN
#undef SEAM
}

extern "C" void kernel_launch(void* const* d_in, const int* in_sizes, int n_in, void* d_out, int out_size, void* d_ws, size_t ws_size, hipStream_t stream) {
    static int grid = 0;
    if (grid == 0) {
        if (n_in != 21 || out_size != (int)O_END || ws_size < WS_END) { fprintf(stderr, "kernel_launch: unexpected problem: n_in %d out %d ws %zu (need %zu); nothing launched\n", n_in, out_size, ws_size, (size_t)WS_END); grid = -1; return; }
        int dev = 0, cus = 0, per_cu = 0;
        if (hipGetDevice(&dev) != hipSuccess || hipDeviceGetAttribute(&cus, hipDeviceAttributeMultiprocessorCount, dev) != hipSuccess) { grid = -1; return; }
        if (hipFuncSetAttribute((const void*)fwd, hipFuncAttributeMaxDynamicSharedMemorySize, LDS_BYTES) != hipSuccess) { fprintf(stderr, "kernel_launch: hipFuncSetAttribute failed\n"); grid = -1; return; }
        if (hipOccupancyMaxActiveBlocksPerMultiprocessor(&per_cu, (const void*)fwd, NTHREADS, LDS_BYTES) != hipSuccess || per_cu < 1) { fprintf(stderr, "kernel_launch: occupancy query says %d blocks per CU\n", per_cu); }
        (void)hipGetLastError();
        grid = cus;
    }
    if (grid < 0) return;
    if (hipMemsetAsync((char*)d_ws + WS_CTL, 0, CTL_ZERO_BYTES, stream) != hipSuccess) return;
    Args a{};
    for (int i = 0; i < 21; ++i) a.in[i] = (const float*)d_in[i];
    a.out = (float*)d_out; a.ws = (unsigned char*)d_ws;
    if (MK_N_LAUNCHES == 1) { a.ph_lo = 0; a.ph_hi = NPH; hipLaunchKernelGGL(fwd, dim3(grid), dim3(NTHREADS), LDS_BYTES, stream, a); }
    else for (int p = 0; p < NPH; ++p) { a.ph_lo = p; a.ph_hi = p + 1; hipLaunchKernelGGL(fwd, dim3(grid), dim3(NTHREADS), LDS_BYTES, stream, a); }
}
```

```cpp
#include <hip/hip_runtime.h>
#include <cstdio>
#include <cstdint>
namespace pg8 {
#define PG8_LAS __attribute__((address_space(3)))
typedef unsigned short bf16_t;
typedef short bf16x8 __attribute__((ext_vector_type(8)));
typedef float f32x4 __attribute__((ext_vector_type(4)));
typedef unsigned u32x4 __attribute__((ext_vector_type(4)));
constexpr int BM = 256, BK = 64, HALF = 128, HTB = HALF * BK * 2  , STAGE_BYTES = 8 * HTB, NXCD = 8, WGM = 8;

__host__ __device__ __forceinline__ int lds_byte(int r, int c) { const int ob = (r & 7) * 64 + (c & 31) * 2; return (r >> 3) * 1024 + (c >> 5) * 512 + (ob ^ (((r >> 2) & 1) << 5)); }
__host__ __device__ __forceinline__ void stage_rc(int b, int& R, int& C) { const int sub = b / 1024, sb = b % 1024, kh = sb >> 9, ob = sb & 511, rr = ob >> 6, pre = ob ^ (((rr >> 2) & 1) << 5); R = sub * 8 + rr; C = kh * 32 + (pre & 63) / 2; }
__host__ __device__ __forceinline__ int perm32(int rho) { const int n = rho >> 4, i = rho & 15; return 8 * (i >> 2) + 4 * n + (i & 3); }

struct Unit { int pm, pn, slot; };
struct Gemm { const bf16_t* A; const bf16_t* Bt; int M, N, K; };

struct StaticOrder {
    int nM, nN, nwg, G, c;
    __host__ __device__ void init(int M, int N, int G_, int c_) { nM = M / BM; nN = N / BM; nwg = nM * nN; G = G_; c = c_; }
    __host__ __device__ bool next(int i, Unit& u) const {
        const long L = (long)i * G + c; if (L >= nwg) return false;
        int wgid = (int)L; { const int q = nwg / NXCD, r = nwg % NXCD, xcd = wgid % NXCD, off = wgid / NXCD; wgid = (xcd < r ? xcd * (q + 1) : r * (q + 1) + (xcd - r) * q) + off; }
        const int nig = WGM * nN, gid = wgid / nig, fm = gid * WGM, gsz = (nM - fm) < WGM ? (nM - fm) : WGM;
        u.pm = fm + ((wgid % nig) % gsz); u.pn = (wgid % nig) / gsz; u.slot = i; return true;
    }
    __device__ __forceinline__ void a_ready(const Unit&) const {}
    __device__ __forceinline__ void done(const Unit&) const {}
};

__device__ __forceinline__ unsigned cvt_pk_bf16(float lo, float hi) { unsigned r; asm volatile("v_cvt_pk_bf16_f32 %0, %1, %2" : "=v"(r) : "v"(lo), "v"(hi)); return r; }
typedef float f32x2 __attribute__((ext_vector_type(2)));
constexpr int XD = 1024;
__device__ __forceinline__ float row_rstd(const float* SS, int r) {
    const f32x4* p = (const f32x4*)(SS + (size_t)r * 16);
    const f32x4 a = p[0], b = p[1], c = p[2], d = p[3];
    const float s = ((a[0] + a[1]) + (a[2] + a[3])) + ((b[0] + b[1]) + (b[2] + b[3])) + ((c[0] + c[1]) + (c[2] + c[3])) + ((d[0] + d[1]) + (d[2] + d[3]));
    return __builtin_amdgcn_rsqf(s * (1.0f / 1024.0f) + 1e-6f);
}
__device__ __forceinline__ float row_rstd32(const float* SSS, int sr) {
    const f32x4* p = (const f32x4*)(SSS + (size_t)sr * 32); float s = 0.f;
#pragma unroll
    for (int j = 0; j < 8; ++j) { const f32x4 a = p[j]; s += (a[0] + a[1]) + (a[2] + a[3]); }
    return __builtin_amdgcn_rsqf(s * (1.0f / 1024.0f) + 1e-6f);
}
__device__ __forceinline__ float any_rstd(const float* SS, const float* SSS, int r) { return r < 16384 ? row_rstd(SS, r) : (r < 16512 ? row_rstd32(SSS, r - 16384) : 1.0f); }
constexpr int RS_TAB_OFF = 131072;
template <class Sched>
__device__ __forceinline__ void fill_rstd_table(PG8_LAS unsigned char* ldsbase, const Sched& S, const float* SS, const float* SSS) {
    int tid_ = threadIdx.x; asm volatile("" : "+v"(tid_));
    const int row = tid_ & 255, half = tid_ >> 8;
    PG8_LAS float* tab = (PG8_LAS float*)(ldsbase + RS_TAB_OFF);
    Unit un[4]; bool ok[4]; f32x4 v[4][4];
#pragma unroll
    for (int j = 0; j < 4; ++j) { ok[j] = S.next(2 * j + half, un[j]); int r = ok[j] ? un[j].pm * BM + row : 0; r = r < 16384 ? r : 16383;
        const f32x4* p = (const f32x4*)(SS + (size_t)r * 16);
#pragma unroll
        for (int q = 0; q < 4; ++q) v[j][q] = p[q]; }
#pragma unroll
    for (int j = 0; j < 4; ++j) { float s = 0.f;
#pragma unroll
        for (int q = 0; q < 4; ++q) s += (v[j][q][0] + v[j][q][1]) + (v[j][q][2] + v[j][q][3]);
        float rs = __builtin_amdgcn_rsqf(s * (1.0f / 1024.0f) + 1e-6f);
        if (ok[j] && un[j].pm >= 64) { const int r = un[j].pm * BM + row; rs = r < 16512 ? row_rstd32(SSS, r - 16384) : 1.0f; }
        if (ok[j]) tab[(2 * j + half) * 256 + row] = rs; }
    __syncthreads();
}
__device__ __forceinline__ float silu_f(float x) { return x * __builtin_amdgcn_rcpf(1.0f + __builtin_amdgcn_exp2f(-1.4426950408889634f * x)); }
__device__ __forceinline__ float gelu_tanh_f(float x) {
    const float a = x * (1.0f + 0.044715f * x * x) * (-2.0f * 0.7978845608028654f * 1.4426950408889634f);
    return x * __builtin_amdgcn_rcpf(1.0f + __builtin_amdgcn_exp2f(a));
}
struct EpiSwiglu {
    static constexpr bool PERM = true, AFTER_DRAIN = false;
    bf16_t* H; const PG8_LAS float* tab; int ldh;
    __device__ __forceinline__ void operator()(const f32x4 (&acc)[2][2][4][2], const Unit& u, int wr, int wc, int fr, int fq) const {
        const int row0 = u.pm * BM + wr * 64 + fr, col0 = u.pn * HALF + wc * 32 + 8 * fq;
        float rsv[2][4];
#pragma unroll
        for (int ai = 0; ai < 2; ++ai)
#pragma unroll
            for (int m = 0; m < 4; ++m) rsv[ai][m] = tab[u.slot * 256 + ((row0 + ai * HALF + m * 16) & 255)];
#pragma unroll
        for (int ai = 0; ai < 2; ++ai)
#pragma unroll
            for (int m = 0; m < 4; ++m) { const int r = row0 + ai * HALF + m * 16; const float rs = rsv[ai][m];
                const float k1 = rs * -1.4426950408889634f, ir2 = __builtin_amdgcn_rcpf(rs * rs);
                float h[8], t[8];
#pragma unroll
                for (int i = 0; i < 8; ++i) t[i] = acc[ai][0][m][i >> 2][i & 3] * k1;
#pragma unroll
                for (int i = 0; i < 8; ++i) h[i] = acc[ai][0][m][i >> 2][i & 3] * acc[ai][1][m][i >> 2][i & 3];
                __builtin_amdgcn_sched_barrier(0);
#pragma unroll
                for (int i = 0; i < 8; ++i) t[i] = __builtin_amdgcn_exp2f(t[i]);
                __builtin_amdgcn_sched_barrier(0);
#pragma unroll
                for (int i = 0; i < 8; ++i) t[i] = __builtin_fmaf(t[i], ir2, ir2);
                __builtin_amdgcn_sched_barrier(0);
#pragma unroll
                for (int i = 0; i < 8; ++i) t[i] = __builtin_amdgcn_rcpf(t[i]);
                __builtin_amdgcn_sched_barrier(0);
#pragma unroll
                for (int i = 0; i < 8; ++i) h[i] *= t[i];
                u32x4 w; w.x = cvt_pk_bf16(h[0], h[1]); w.y = cvt_pk_bf16(h[2], h[3]); w.z = cvt_pk_bf16(h[4], h[5]); w.w = cvt_pk_bf16(h[6], h[7]);
                *(u32x4*)(H + (size_t)r * ldh + col0) = w;
#ifdef PROBE_ST2
                { __attribute__((address_space(1))) u32x4* p2 = (__attribute__((address_space(1))) u32x4*)(H + (size_t)r * ldh + col0); asm volatile("" : "+v"(p2) :: "memory"); *p2 = w; }
#endif
 }
    }
};
struct EpiResid {
    static constexpr bool PERM = true, AFTER_DRAIN = false;
    float* X; bf16_t* XB; float* SS; float scale;
    __device__ __forceinline__ void operator()(const f32x4 (&acc)[2][2][4][2], const Unit& u, int wr, int wc, int fr, int fq) const {
        const int row0 = u.pm * BM + wr * 64 + fr, col0 = u.pn * BM + wc * 32 + 8 * fq;
        const unsigned voff = (unsigned)(row0 * XD + col0) * 2u; char* const xbase = (char*)XB;
        u32x4 xo[2][4][2];
#pragma unroll
        for (int ai = 0; ai < 2; ++ai)
#pragma unroll
            for (int m = 0; m < 4; ++m)
#pragma unroll
                for (int bj = 0; bj < 2; ++bj) xo[ai][m][bj] = *(const u32x4*)(xbase + (voff + (unsigned)(((ai * HALF + m * 16) * XD + bj * HALF) * 2)));
        asm volatile("" ::: "memory");
        float ssv[2][4];
#pragma unroll
        for (int ai = 0; ai < 2; ++ai)
#pragma unroll
            for (int m = 0; m < 4; ++m) { float ss = 0.f;
#pragma unroll
                for (int bj = 0; bj < 2; ++bj) { const unsigned off = voff + (unsigned)(((ai * HALF + m * 16) * XD + bj * HALF) * 2);
                    const u32x4 o = xo[ai][m][bj];
                    f32x4 xa, xb; xa[0] = __builtin_bit_cast(float, o.x << 16); xa[1] = __builtin_bit_cast(float, o.x & 0xffff0000u); xa[2] = __builtin_bit_cast(float, o.y << 16); xa[3] = __builtin_bit_cast(float, o.y & 0xffff0000u);
                    xb[0] = __builtin_bit_cast(float, o.z << 16); xb[1] = __builtin_bit_cast(float, o.z & 0xffff0000u); xb[2] = __builtin_bit_cast(float, o.w << 16); xb[3] = __builtin_bit_cast(float, o.w & 0xffff0000u);
                    xa = xa + acc[ai][bj][m][0] * scale; xb = xb + acc[ai][bj][m][1] * scale;
                    u32x4 w; w.x = cvt_pk_bf16(xa[0], xa[1]); w.y = cvt_pk_bf16(xa[2], xa[3]); w.z = cvt_pk_bf16(xb[0], xb[1]); w.w = cvt_pk_bf16(xb[2], xb[3]); *(u32x4*)(xbase + off) = w;
                    const float y0 = __builtin_bit_cast(float, w.x << 16), y1 = __builtin_bit_cast(float, w.x & 0xffff0000u), y2 = __builtin_bit_cast(float, w.y << 16), y3 = __builtin_bit_cast(float, w.y & 0xffff0000u);
                    const float y4 = __builtin_bit_cast(float, w.z << 16), y5 = __builtin_bit_cast(float, w.z & 0xffff0000u), y6 = __builtin_bit_cast(float, w.w << 16), y7 = __builtin_bit_cast(float, w.w & 0xffff0000u);
                    ss += ((y0 * y0 + y1 * y1) + (y2 * y2 + y3 * y3)) + ((y4 * y4 + y5 * y5) + (y6 * y6 + y7 * y7)); }
                ss += __shfl_xor(ss, 16); ss += __shfl_xor(ss, 32); ssv[ai][m] = ss; }
#pragma unroll
        for (int ai = 0; ai < 2; ++ai) { const float sel = fq == 0 ? ssv[ai][0] : (fq == 1 ? ssv[ai][1] : (fq == 2 ? ssv[ai][2] : ssv[ai][3]));
            SS[(size_t)(row0 + ai * HALF + fq * 16) * 16 + u.pn * 4 + wc] = sel; }
    }
};
struct EpiQkv {
    static constexpr bool PERM = true, AFTER_DRAIN = false;
    bf16_t* QKV; const PG8_LAS float* tab; float* out; int li;
    __device__ __forceinline__ void operator()(const f32x4 (&acc)[2][2][4][2], const Unit& u, int wr, int wc, int fr, int fq) const {
        const int pm = __builtin_amdgcn_readfirstlane(u.pm), pn = __builtin_amdgcn_readfirstlane(u.pn), wrs = __builtin_amdgcn_readfirstlane(wr), wcs = __builtin_amdgcn_readfirstlane(wc);
        const int row0 = pm * BM + wrs * 64 + fr, dl = (wcs & 1) * 32 + 8 * fq;
        float rsv[2][4];
#pragma unroll
        for (int ai = 0; ai < 2; ++ai)
#pragma unroll
            for (int m = 0; m < 4; ++m) rsv[ai][m] = tab[u.slot * 256 + ((row0 + ai * HALF + m * 16) & 255)];
        int secv[2], gv[2], hhv[2];
#pragma unroll
        for (int bj = 0; bj < 2; ++bj) { const int cw = pn * BM + bj * HALF + wcs * 32, sec = cw / 1536, cc = cw - sec * 1536; secv[bj] = sec; gv[bj] = cc >> 9; hhv[bj] = (cc >> 6) & 7; }
        if (pm < 64) {
            const int b = pm >> 4, tb = (pm & 15) * BM + wrs * 64;
#pragma unroll
            for (int ai = 0; ai < 2; ++ai)
#pragma unroll
                for (int m = 0; m < 4; ++m) { const int ts = tb + ai * HALF + m * 16, t = ts + fr; const float rs = rsv[ai][m];
#pragma unroll
                    for (int bj = 0; bj < 2; ++bj) { const int sec = secv[bj], g = gv[bj], hh = hhv[bj], sh = 2 * g;
                        const f32x4 v0 = acc[ai][bj][m][0] * rs, v1 = acc[ai][bj][m][1] * rs;
                        u32x4 w; w.x = cvt_pk_bf16(v0[0], v0[1]); w.y = cvt_pk_bf16(v0[2], v0[3]); w.z = cvt_pk_bf16(v1[0], v1[1]); w.w = cvt_pk_bf16(v1[2], v1[3]);
                        const int uu = ((t & ((1 << sh) - 1)) << (12 - sh)) + (t >> sh);
                        *(u32x4*)(QKV + ((size_t)(((sec * 4 + b) * 3 + g) * 8 + hh) * 4096) * 64 + (size_t)(uu * 64 + dl)) = w;
                        if (sec > 0) { const int keep = 128 << sh, i0 = ts - (4096 - keep);
                            if (i0 >= 0) { const size_t obase = g == 0 ? 16908288u : (g == 1 ? 17956864u : 22151168u);
                                float* dst = out + obase + ((((size_t)(li * 4 + b) * keep + i0) * 2 + (sec - 1)) * 8 + hh) * 64 + (size_t)(fr * 1024 + dl);
                                *(f32x4*)dst = v0; *(f32x4*)(dst + 4) = v1; } } } }
        } else {
#pragma unroll
            for (int ai = 0; ai < 2; ++ai)
#pragma unroll
                for (int m = 0; m < 4; ++m) { const int r = row0 + ai * HALF + m * 16; const float rs = rsv[ai][m];
#pragma unroll
                    for (int bj = 0; bj < 2; ++bj) { const int sec = secv[bj], g = gv[bj], hh = hhv[bj];
                        const f32x4 v0 = acc[ai][bj][m][0] * rs, v1 = acc[ai][bj][m][1] * rs;
                        u32x4 w; w.x = cvt_pk_bf16(v0[0], v0[1]); w.y = cvt_pk_bf16(v0[2], v0[3]); w.z = cvt_pk_bf16(v1[0], v1[1]); w.w = cvt_pk_bf16(v1[2], v1[3]);
                        *(u32x4*)(QKV + (size_t)r * 4608 + (pn * BM + bj * HALF + wcs * 32 + 8 * fq)) = w;
                        if (sec > 0 && ai == 0) { const int sr = wrs * 64 + m * 16 + fr;
                            const size_t obase = g == 0 ? 38928384u : (g == 1 ? 39190528u : 39452672u);
                            float* dst = out + obase + (((size_t)(li * 128) * 2 + (sec - 1)) * 8 + hh) * 64 + (size_t)(sr * 1024 + dl);
                            *(f32x4*)dst = v0; *(f32x4*)(dst + 4) = v1; } } }
        }
    }
};
struct EpiUv {
    static constexpr bool PERM = true, AFTER_DRAIN = false;
    bf16_t* UV; const PG8_LAS float* tab; float* VS;
    __device__ __forceinline__ void operator()(const f32x4 (&acc)[2][2][4][2], const Unit& u, int wr, int wc, int fr, int fq) const {
        typedef float f32x2 __attribute__((ext_vector_type(2)));
        const int row0 = u.pm * BM + wr * 64 + fr; const bool vhalf = u.pn >= 12;
        float rsv[2][4], sv1[2][4], sv2[2][4];
#pragma unroll
        for (int ai = 0; ai < 2; ++ai)
#pragma unroll
            for (int m = 0; m < 4; ++m) rsv[ai][m] = tab[u.slot * 256 + ((row0 + ai * HALF + m * 16) & 255)];
#pragma unroll
        for (int ai = 0; ai < 2; ++ai)
#pragma unroll
            for (int m = 0; m < 4; ++m) { const int r = row0 + ai * HALF + m * 16; const float rs = rsv[ai][m]; float s1 = 0.f, s2 = 0.f;
                const float C0 = -2.0f * 0.7978845608028654f * 1.4426950408889634f, K0 = C0 * rs, K1 = (C0 * 0.044715f) * rs * rs * rs, irs = __builtin_amdgcn_rcpf(rs);
#pragma unroll
                for (int bj = 0; bj < 2; ++bj) { const int c0 = u.pn * BM + bj * HALF + wc * 32 + 8 * fq; float h[8], t[8];
#pragma unroll
                    for (int i = 0; i < 8; ++i) t[i] = acc[ai][bj][m][i >> 2][i & 3] * acc[ai][bj][m][i >> 2][i & 3];
#pragma unroll
                    for (int i = 0; i < 8; ++i) t[i] = __builtin_fmaf(t[i], K1, K0);
#pragma unroll
                    for (int i = 0; i < 8; ++i) t[i] *= acc[ai][bj][m][i >> 2][i & 3];
                    __builtin_amdgcn_sched_barrier(0);
#pragma unroll
                    for (int i = 0; i < 8; ++i) t[i] = __builtin_amdgcn_exp2f(t[i]);
                    __builtin_amdgcn_sched_barrier(0);
#pragma unroll
                    for (int i = 0; i < 8; ++i) t[i] = __builtin_fmaf(t[i], irs, irs);
                    __builtin_amdgcn_sched_barrier(0);
#pragma unroll
                    for (int i = 0; i < 8; ++i) t[i] = __builtin_amdgcn_rcpf(t[i]);
                    __builtin_amdgcn_sched_barrier(0);
#pragma unroll
                    for (int i = 0; i < 8; ++i) h[i] = acc[ai][bj][m][i >> 2][i & 3] * t[i];
                    if (vhalf) {
#pragma unroll
                        for (int i = 0; i < 8; ++i) { s1 += h[i]; s2 = __builtin_fmaf(h[i], h[i], s2); } }
                    u32x4 w; w.x = cvt_pk_bf16(h[0], h[1]); w.y = cvt_pk_bf16(h[2], h[3]); w.z = cvt_pk_bf16(h[4], h[5]); w.w = cvt_pk_bf16(h[6], h[7]);
                    *(u32x4*)(UV + (size_t)r * 6144 + c0) = w; }
                if (vhalf) { s1 += __shfl_xor(s1, 16); s1 += __shfl_xor(s1, 32); s2 += __shfl_xor(s2, 16); s2 += __shfl_xor(s2, 32); }
                sv1[ai][m] = s1; sv2[ai][m] = s2; }
        if (vhalf) {
#pragma unroll
            for (int ai = 0; ai < 2; ++ai) { const float a1 = fq == 0 ? sv1[ai][0] : (fq == 1 ? sv1[ai][1] : (fq == 2 ? sv1[ai][2] : sv1[ai][3])), a2 = fq == 0 ? sv2[ai][0] : (fq == 1 ? sv2[ai][1] : (fq == 2 ? sv2[ai][2] : sv2[ai][3]));
                *(f32x2*)(VS + ((size_t)(row0 + ai * HALF + fq * 16) * 48 + (u.pn - 12) * 4 + wc) * 2) = (f32x2){a1, a2}; } }
    }
};
template <class Epi, class Sched, bool ALIGN_EPI = false, bool SP2 = false>
__device__ __forceinline__ void gemm_phase(PG8_LAS unsigned char* lds, const Gemm g, const Sched& S, const Epi& E, const bool preB = false) {
    int tid_ = threadIdx.x; asm volatile("" : "+v"(tid_));
    const int tid = tid_, wid = __builtin_amdgcn_readfirstlane(tid >> 6), lane = tid & 63, wr = wid >> 2, wc = wid & 3, fr = lane & 15, fq = lane >> 4;
    const int K = g.K, nt = K / BK;
    unsigned voffA[2], voffB[2];
#pragma unroll
    for (int i = 0; i < 2; ++i) { int R, C; stage_rc(tid * 16 + i * 8192, R, C); const int Rb = Epi::PERM ? ((R & ~31) + perm32(R & 31)) : R;
        voffA[i] = (unsigned)(R * K + C) * 2u; voffB[i] = (unsigned)(Rb * K + C) * 2u; }
    const size_t kstep = (size_t)(BK * 2);
    const size_t hstep = (size_t)HALF * K * 2;
    const size_t tstep = 2 * hstep;
    const unsigned ldsw = (unsigned)wid * 1024u;
    const int aoff = lds_byte(wr * 64 + fr, fq * 8), boff = lds_byte(wc * 32 + fr, fq * 8);
#define PG8_SA(b, h) (((b) * 2 + (h)) * HTB)
#define PG8_SB(b, h) ((4 + (b) * 2 + (h)) * HTB)
#define PG8_STAGE(bufoff, gbase, voff) do { _Pragma("unroll") for (int _i = 0; _i < 2; ++_i) { \
        const unsigned _m0 = (unsigned)__builtin_amdgcn_readfirstlane((int)(unsigned)(__UINTPTR_TYPE__)(lds + (bufoff) + ldsw + _i * 8192)); \
        asm volatile("s_mov_b32 m0, %2\n\ts_nop 0\n\tglobal_load_lds_dwordx4 %0, %1" :: "v"((voff)[_i]), "s"((const char*)(gbase)), "s"(_m0) : "memory"); } } while (0)
#define PG8_LDA(dst, b, h) do { _Pragma("unroll") for (int m = 0; m < 4; ++m) _Pragma("unroll") for (int k = 0; k < 2; ++k) dst[m][k] = *(const PG8_LAS bf16x8*)(lds + PG8_SA(b, h) + aoff + m * 2048 + k * 512); } while (0)
#define PG8_LDB(dst, b, h) do { _Pragma("unroll") for (int n = 0; n < 2; ++n) _Pragma("unroll") for (int k = 0; k < 2; ++k) dst[n][k] = *(const PG8_LAS bf16x8*)(lds + PG8_SB(b, h) + boff + n * 2048 + k * 512); } while (0)
#define PG8_MMA(ai, bj, At, Bt) do { _Pragma("unroll") for (int m = 0; m < 4; ++m) _Pragma("unroll") for (int n = 0; n < 2; ++n) _Pragma("unroll") for (int k = 0; k < 2; ++k) \
        acc[ai][bj][m][n] = __builtin_amdgcn_mfma_f32_16x16x32_bf16(Bt[n][k], At[m][k], acc[ai][bj][m][n], 0, 0, 0); } while (0)
#define PG8_MMA4(ai, bj, m, At, Bt) do { _Pragma("unroll") for (int n = 0; n < 2; ++n) _Pragma("unroll") for (int k = 0; k < 2; ++k) \
        acc[ai][bj][m][n] = __builtin_amdgcn_mfma_f32_16x16x32_bf16(Bt[n][k], At[m][k], acc[ai][bj][m][n], 0, 0, 0); } while (0)
#define PG8_PIECE(bufoff, gbase, voff, i) do { __builtin_amdgcn_sched_barrier(0); \
        { const unsigned _m0 = (unsigned)__builtin_amdgcn_readfirstlane((int)(unsigned)(__UINTPTR_TYPE__)(lds + (bufoff) + ldsw + (i) * 8192)); \
          asm volatile("s_mov_b32 m0, %2\n\ts_nop 0\n\tglobal_load_lds_dwordx4 %0, %1" :: "v"((voff)[i]), "s"((const char*)(gbase)), "s"(_m0) : "memory"); } __builtin_amdgcn_sched_barrier(0); } while (0)
#define PG8_MMA_ST3(ai, At, o0, g0, v0, o1, g1, v1, o2, g2, v2) do { \
        PG8_MMA4(ai, 0, 0, At, B0); PG8_MMA4(ai, 0, 1, At, B0); PG8_PIECE(o0, g0, v0, 0); PG8_MMA4(ai, 0, 2, At, B0); PG8_PIECE(o0, g0, v0, 1); PG8_MMA4(ai, 0, 3, At, B0); PG8_PIECE(o1, g1, v1, 0); \
        PG8_MMA4(ai, 1, 0, At, B1); PG8_PIECE(o1, g1, v1, 1); PG8_MMA4(ai, 1, 1, At, B1); PG8_PIECE(o2, g2, v2, 0); PG8_MMA4(ai, 1, 2, At, B1); PG8_PIECE(o2, g2, v2, 1); PG8_MMA4(ai, 1, 3, At, B1); } while (0)
#define PG8_PRIO(x) __builtin_amdgcn_s_setprio(x)
#define PG8_WAIT_V(n) asm volatile("s_waitcnt vmcnt(" #n ")" ::: "memory")
#define PG8_WAIT_L(n) asm volatile("s_waitcnt lgkmcnt(" #n ")" ::: "memory")
#define PG8_BAR __builtin_amdgcn_s_barrier()
#define PG8_SCHED __builtin_amdgcn_sched_barrier(0)
    Unit cur, nxt; int ui = 0;
    if (!S.next(0, cur)) return;
    f32x4 acc[2][2][4][2];
#pragma unroll
    for (int a = 0; a < 2; ++a)
#pragma unroll
        for (int b = 0; b < 2; ++b)
#pragma unroll
            for (int m = 0; m < 4; ++m)
#pragma unroll
                for (int n = 0; n < 2; ++n) acc[a][b][m][n] = (f32x4){0.f, 0.f, 0.f, 0.f};
    bf16x8 At[4][2], B0[2][2], B1[2][2];
    const char* cA = (const char*)g.A + (size_t)cur.pm * tstep; const char* cB = (const char*)g.Bt + (size_t)cur.pn * tstep;
    S.a_ready(cur);
    if constexpr (SP2) {
        if (!preB) { PG8_STAGE(PG8_SB(0, 0), cB, voffB); PG8_STAGE(PG8_SB(0, 1), cB + hstep, voffB); }
        PG8_STAGE(PG8_SA(0, 0), cA, voffA); PG8_STAGE(PG8_SA(0, 1), cA + hstep, voffA);
        if (wr == 1) PG8_BAR;
        PG8_WAIT_V(2); PG8_BAR;
        if (!preB) { PG8_STAGE(PG8_SB(1, 0), cB + kstep, voffB); PG8_STAGE(PG8_SA(1, 0), cA + kstep, voffA); PG8_STAGE(PG8_SB(1, 1), cB + hstep + kstep, voffB);
            PG8_WAIT_V(6); }
        else { PG8_STAGE(PG8_SA(1, 0), cA + kstep, voffA); PG8_WAIT_V(2); }
        PG8_BAR;
    } else {
        PG8_STAGE(PG8_SB(0, 0), cB, voffB); PG8_STAGE(PG8_SA(0, 0), cA, voffA); PG8_STAGE(PG8_SB(0, 1), cB + hstep, voffB); PG8_STAGE(PG8_SA(0, 1), cA + hstep, voffA);
        if (wr == 1) PG8_BAR;
        PG8_WAIT_V(4); PG8_BAR;
        PG8_STAGE(PG8_SB(1, 0), cB + kstep, voffB); PG8_STAGE(PG8_SA(1, 0), cA + kstep, voffA); PG8_STAGE(PG8_SB(1, 1), cB + hstep + kstep, voffB);
        PG8_WAIT_V(6); PG8_BAR;
    }
    for (;;) {
        const bool has_next = S.next(ui + 1, nxt);
        const char* nA = has_next ? (const char*)g.A + (size_t)nxt.pm * tstep : cA; const char* nB = has_next ? (const char*)g.Bt + (size_t)nxt.pn * tstep : cB;
        const int nt_main = (SP2 && !has_next) ? nt - 2 : nt;
        for (int t = 0; t < nt_main; t += 2) {
            const bool last = (t == nt - 2);
            const char* a1 = cA + (size_t)(t + 1) * kstep;
            const char* a2 = last ? nA : cA + (size_t)(t + 2) * kstep; const char* b2 = last ? nB : cB + (size_t)(t + 2) * kstep;
            const char* a3 = a2 + kstep; const char* b3 = b2 + kstep;
            if (last && has_next) S.a_ready(nxt);
            if constexpr (SP2) {
            PG8_LDB(B0, 0, 0); PG8_LDB(B1, 0, 1); PG8_SCHED; PG8_LDA(At, 0, 0); PG8_STAGE(PG8_SA(1, 1), a1 + hstep, voffA);
            PG8_WAIT_V(8); PG8_WAIT_L(0); PG8_BAR; PG8_PRIO(1); PG8_MMA(0, 0, At, B0); PG8_MMA(0, 1, At, B1); PG8_PRIO(0); PG8_BAR; PG8_SCHED;
            PG8_LDA(At, 0, 1);
            PG8_WAIT_V(2); PG8_WAIT_L(0); PG8_BAR; PG8_PRIO(1); PG8_MMA_ST3(1, At, PG8_SB(0, 0), b2, voffB, PG8_SB(0, 1), b2 + hstep, voffB, PG8_SA(0, 0), a2, voffA); PG8_PRIO(0); PG8_BAR; PG8_SCHED;
            PG8_LDB(B0, 1, 0); PG8_LDB(B1, 1, 1); PG8_SCHED; PG8_LDA(At, 1, 0); PG8_STAGE(PG8_SA(0, 1), a2 + hstep, voffA);
            PG8_WAIT_V(8); PG8_WAIT_L(0); PG8_BAR; PG8_PRIO(1); PG8_MMA(0, 0, At, B0); PG8_MMA(0, 1, At, B1); PG8_PRIO(0); PG8_BAR; PG8_SCHED;
            PG8_LDA(At, 1, 1);
            PG8_WAIT_V(2); PG8_WAIT_L(0); PG8_BAR; PG8_PRIO(1); PG8_MMA_ST3(1, At, PG8_SB(1, 0), b3, voffB, PG8_SB(1, 1), b3 + hstep, voffB, PG8_SA(1, 0), a3, voffA); PG8_PRIO(0); PG8_BAR; PG8_SCHED;
            } else {
            PG8_LDB(B0, 0, 0); PG8_SCHED; PG8_LDA(At, 0, 0); PG8_STAGE(PG8_SA(1, 1), a1 + hstep, voffA);
            PG8_WAIT_L(8); PG8_BAR; PG8_WAIT_L(0); PG8_PRIO(1); PG8_MMA(0, 0, At, B0); PG8_PRIO(0); PG8_BAR; PG8_SCHED;
            PG8_LDB(B1, 0, 1); PG8_STAGE(PG8_SB(0, 0), b2, voffB);
            PG8_BAR; PG8_WAIT_L(0); PG8_PRIO(1); PG8_MMA(0, 1, At, B1); PG8_PRIO(0); PG8_BAR;
            PG8_LDA(At, 0, 1); PG8_STAGE(PG8_SA(0, 0), a2, voffA);
            PG8_BAR; PG8_WAIT_L(0); PG8_PRIO(1); PG8_MMA(1, 0, At, B0); PG8_PRIO(0); PG8_BAR; PG8_SCHED;
            PG8_STAGE(PG8_SB(0, 1), b2 + hstep, voffB);
            PG8_WAIT_V(6); PG8_BAR; PG8_PRIO(1); PG8_MMA(1, 1, At, B1); PG8_PRIO(0); PG8_BAR;
            PG8_LDB(B0, 1, 0); PG8_SCHED; PG8_LDA(At, 1, 0); PG8_STAGE(PG8_SA(0, 1), a2 + hstep, voffA);
            PG8_WAIT_L(8); PG8_BAR; PG8_WAIT_L(0); PG8_PRIO(1); PG8_MMA(0, 0, At, B0); PG8_PRIO(0); PG8_BAR; PG8_SCHED;
            PG8_LDB(B1, 1, 1); PG8_STAGE(PG8_SB(1, 0), b3, voffB);
            PG8_BAR; PG8_WAIT_L(0); PG8_PRIO(1); PG8_MMA(0, 1, At, B1); PG8_PRIO(0); PG8_BAR;
            PG8_LDA(At, 1, 1); PG8_STAGE(PG8_SA(1, 0), a3, voffA);
            PG8_BAR; PG8_WAIT_L(0); PG8_PRIO(1); PG8_MMA(1, 0, At, B0); PG8_PRIO(0); PG8_BAR; PG8_SCHED;
            PG8_STAGE(PG8_SB(1, 1), b3 + hstep, voffB);
            PG8_WAIT_V(6); PG8_BAR; PG8_PRIO(1); PG8_MMA(1, 1, At, B1); PG8_PRIO(0); PG8_BAR;
            }
        }
        if constexpr (SP2) { if (!has_next) { const char* a1 = cA + (size_t)(nt - 1) * kstep;
            PG8_LDB(B0, 0, 0); PG8_LDB(B1, 0, 1); PG8_SCHED; PG8_LDA(At, 0, 0); PG8_STAGE(PG8_SA(1, 1), a1 + hstep, voffA);
            PG8_WAIT_V(8); PG8_WAIT_L(0); PG8_BAR; PG8_PRIO(1); PG8_MMA(0, 0, At, B0); PG8_MMA(0, 1, At, B1); PG8_PRIO(0); PG8_BAR; PG8_SCHED;
            PG8_LDA(At, 0, 1);
            PG8_WAIT_V(2); PG8_WAIT_L(0); PG8_BAR; PG8_PRIO(1); PG8_MMA(1, 0, At, B0); PG8_MMA(1, 1, At, B1); PG8_PRIO(0); PG8_BAR; PG8_SCHED;
            PG8_LDB(B0, 1, 0); PG8_LDB(B1, 1, 1); PG8_SCHED; PG8_LDA(At, 1, 0);
            PG8_WAIT_V(0); PG8_WAIT_L(0); PG8_BAR; PG8_PRIO(1); PG8_MMA(0, 0, At, B0); PG8_MMA(0, 1, At, B1); PG8_PRIO(0); PG8_BAR; PG8_SCHED;
            PG8_LDA(At, 1, 1);
            PG8_WAIT_L(0); PG8_BAR; PG8_PRIO(1); PG8_MMA(1, 0, At, B0); PG8_MMA(1, 1, At, B1); PG8_PRIO(0); PG8_BAR; PG8_SCHED;
        } }
        if constexpr (ALIGN_EPI) { if (wr == 0) PG8_BAR; }
        if constexpr (!Epi::AFTER_DRAIN) { E(acc, cur, wr, wc, fr, fq); S.done(cur); }
        if (!has_next) break;
#pragma unroll
        for (int a = 0; a < 2; ++a)
#pragma unroll
            for (int b = 0; b < 2; ++b)
#pragma unroll
                for (int m = 0; m < 4; ++m)
#pragma unroll
                    for (int n = 0; n < 2; ++n) acc[a][b][m][n] = (f32x4){0.f, 0.f, 0.f, 0.f};
        cur = nxt; cA = nA; cB = nB; ++ui;
        if constexpr (ALIGN_EPI) { if (wr == 1) PG8_BAR; }
    }
    PG8_WAIT_V(0);
    if constexpr (!ALIGN_EPI) { if (wr == 0) PG8_BAR; }
    PG8_BAR;
    if constexpr (Epi::AFTER_DRAIN) { E.fused(acc, cur, wr, wc, fr, fq, lds, wid, lane); S.done(cur); }
#undef PG8_SA
#undef PG8_SB
#undef PG8_STAGE
#undef PG8_LDA
#undef PG8_LDB
#undef PG8_MMA
#undef PG8_PRIO
#undef PG8_MMA4
#undef PG8_PIECE
#undef PG8_MMA_ST3
#undef PG8_WAIT_V
#undef PG8_WAIT_L
#undef PG8_BAR
#undef PG8_SCHED
}
template <bool PERM, class Sched>
__device__ __forceinline__ void gemm_prefetch_b(PG8_LAS unsigned char* lds, const bf16_t* Bt, int K, const Sched& S, const int part) {
    int tid_ = threadIdx.x; asm volatile("" : "+v"(tid_));
    const int tid = tid_, wid = __builtin_amdgcn_readfirstlane(tid >> 6);
    if ((wid == 0) != (part == 1)) return;
    Unit cur; if (!S.next(0, cur)) return;
    const size_t hstep = (size_t)HALF * K * 2; const char* cB = (const char*)Bt + (size_t)cur.pn * 2 * hstep;
#pragma unroll
    for (int i = 0; i < 2; ++i) { int R, C; stage_rc(tid * 16 + i * 8192, R, C); const int Rb = PERM ? ((R & ~31) + perm32(R & 31)) : R; const unsigned vo = (unsigned)(Rb * K + C) * 2u;
#pragma unroll
        for (int b = 0; b < 2; ++b)
#pragma unroll
            for (int h = 0; h < 2; ++h)
                __builtin_amdgcn_global_load_lds((const unsigned*)(cB + (size_t)h * hstep + (size_t)b * (BK * 2) + vo), (PG8_LAS unsigned*)(lds + (4 + b * 2 + h) * HTB + (unsigned)wid * 1024u + i * 8192), 16, 0, 0); }
}
}
#define GAS __attribute__((address_space(1)))
#define LAS __attribute__((address_space(3)))
typedef unsigned short bf16;
typedef unsigned v4u __attribute__((ext_vector_type(4)));
typedef float f32x4 __attribute__((ext_vector_type(4)));
typedef short bf16x8 __attribute__((ext_vector_type(8)));
typedef GAS unsigned gu32;
typedef GAS unsigned long long gu64;
#define RLX_AGENT __ATOMIC_RELAXED, __HIP_MEMORY_SCOPE_AGENT
#define LDS_WAIT() asm volatile("s_waitcnt lgkmcnt(0)" ::: "memory")
#define VM_WAIT() asm volatile("s_waitcnt vmcnt(0)" ::: "memory")
__device__ __forceinline__ unsigned long long rt() { return __builtin_amdgcn_s_memrealtime(); }
__device__ __forceinline__ unsigned f2bf(float f) { unsigned u = __builtin_bit_cast(unsigned, f); return (u + 0x7fffu + ((u >> 16) & 1u)) >> 16; }
__device__ __forceinline__ unsigned pk2(float lo, float hi) { return f2bf(lo) | (f2bf(hi) << 16); }

#define XB_TMO      128
#define XB_XCNT(j)  (256  + 64 * (j))
#define XB_XSUB(j)  (1280 + 64 * (j))
#define XB_XGEN(j)  (2304 + 64 * (j))
#define XB_TOP      3328
#define XB_TOPGEN   3392
#define XCD_BAR_WORDS 3456
#define XB_SPIN_CAP (1u << 18)

__device__ __forceinline__ unsigned xb_ld(unsigned* p)              { return __hip_atomic_load(p, __ATOMIC_RELAXED, __HIP_MEMORY_SCOPE_AGENT); }
__device__ __forceinline__ unsigned xb_add(unsigned* p, unsigned v) { return __hip_atomic_fetch_add(p, v, __ATOMIC_RELAXED, __HIP_MEMORY_SCOPE_AGENT); }
__device__ __forceinline__ unsigned xb_xcc_id() { return (unsigned)__builtin_amdgcn_s_getreg((3 << 11) | 20) & 0xFu; }
#define XB_SPIN(cond, bar) do { unsigned _sp = 0; while (cond) { __builtin_amdgcn_s_sleep(1); \
    if ((++_sp & 255u) == 0u) { if (xb_ld(&(bar)[XB_TMO])) break; if (_sp > XB_SPIN_CAP) { atomicAdd(&(bar)[XB_TMO], 1u); break; } } } } while (0)

struct XcdBarrier {
    unsigned* bar; unsigned x;
    volatile LAS unsigned* st;
};

__device__ __forceinline__ XcdBarrier xcd_barrier_post(unsigned* bar, volatile LAS unsigned* st) {
    XcdBarrier b; b.bar = bar; b.x = xb_xcc_id(); b.st = st;
    if (threadIdx.x == 0) (void)xb_add(&bar[XB_XCNT(b.x)], 1u);
    return b;
}
__device__ __forceinline__ void xcd_barrier_complete(unsigned* bar, unsigned x, unsigned& nloc, unsigned& nx) {
    const unsigned G = gridDim.x * gridDim.y * gridDim.z;
    unsigned sum, cnt, mine, sp = 0u;
    for (;;) {
        sum = 0u; cnt = 0u; mine = 0u;
#pragma unroll
        for (unsigned j = 0; j < 16; ++j) { const unsigned c = xb_ld(&bar[XB_XCNT(j)]); sum += c; cnt += (c > 0u) ? 1u : 0u; mine = (j == x) ? c : mine; }
        if (sum == G) break;
        __builtin_amdgcn_s_sleep(1);
        if ((++sp & 255u) == 0u) { if (xb_ld(&bar[XB_TMO])) break; if (sp > XB_SPIN_CAP) { atomicAdd(&bar[XB_TMO], 1u); break; } }
    }
    nloc = mine > 0u ? mine : 1u; nx = cnt > 0u ? cnt : 1u;
}

__device__ __forceinline__ void xcd_barrier(const XcdBarrier& b) {
    asm volatile("s_waitcnt vmcnt(0)" ::: "memory");
    __syncthreads();
    if (threadIdx.x == 0) {
        unsigned* bar = b.bar; unsigned bx_ = b.x; asm volatile("" : "+s"(bx_));
        __builtin_amdgcn_s_waitcnt(0);
        unsigned nloc = b.st[0], nx = b.st[1];
        if (nloc == 0u) { xcd_barrier_complete(bar, bx_, nloc, nx); b.st[0] = nloc; b.st[1] = nx; }
        const unsigned old = xb_add(&bar[XB_XSUB(bx_)], 1u);
        const unsigned gen = old / nloc;
        if (old + 1u == (gen + 1u) * nloc) {
            __builtin_amdgcn_fence(__ATOMIC_RELEASE, "agent");
            asm volatile("s_waitcnt vmcnt(0)" ::: "memory");
            const unsigned og = xb_add(&bar[XB_TOP], 1u);
            const unsigned tg = og / nx;
            if (og + 1u == (tg + 1u) * nx) xb_add(&bar[XB_TOPGEN], 1u);
            else XB_SPIN(xb_ld(&bar[XB_TOPGEN]) == tg, bar);
            __builtin_amdgcn_fence(__ATOMIC_ACQUIRE, "agent");
            xb_add(&bar[XB_XGEN(bx_)], 1u);
            asm volatile("s_waitcnt vmcnt(0)" ::: "memory");
        } else {
            XB_SPIN(xb_ld(&bar[XB_XGEN(bx_)]) == gen, bar);
            __builtin_amdgcn_fence(__ATOMIC_ACQUIRE, "agent");
            asm volatile("s_waitcnt vmcnt(0)" ::: "memory");
        }
    }
    __syncthreads();
}
__device__ __forceinline__ void xcd_barrier_head() { asm volatile("s_waitcnt vmcnt(0)" ::: "memory"); __syncthreads(); }
__device__ __forceinline__ void xcd_barrier_tail(const XcdBarrier& b) {
    if (threadIdx.x == 0) {
        unsigned* bar = b.bar; unsigned bx_ = b.x; asm volatile("" : "+s"(bx_));
        __builtin_amdgcn_s_waitcnt(0);
        unsigned nloc = b.st[0], nx = b.st[1];
        if (nloc == 0u) { xcd_barrier_complete(bar, bx_, nloc, nx); b.st[0] = nloc; b.st[1] = nx; }
        const unsigned old = xb_add(&bar[XB_XSUB(bx_)], 1u);
        const unsigned gen = old / nloc;
        if (old + 1u == (gen + 1u) * nloc) {
            __builtin_amdgcn_fence(__ATOMIC_RELEASE, "agent");
            asm volatile("s_waitcnt vmcnt(0)" ::: "memory");
            const unsigned og = xb_add(&bar[XB_TOP], 1u);
            const unsigned tg = og / nx;
            if (og + 1u == (tg + 1u) * nx) xb_add(&bar[XB_TOPGEN], 1u);
            else XB_SPIN(xb_ld(&bar[XB_TOPGEN]) == tg, bar);
            __builtin_amdgcn_fence(__ATOMIC_ACQUIRE, "agent");
            xb_add(&bar[XB_XGEN(bx_)], 1u);
            asm volatile("s_waitcnt vmcnt(0)" ::: "memory");
        } else {
            XB_SPIN(xb_ld(&bar[XB_XGEN(bx_)]) == gen, bar);
            __builtin_amdgcn_fence(__ATOMIC_ACQUIRE, "agent");
            asm volatile("s_waitcnt vmcnt(0)" ::: "memory");
        }
    }
    __syncthreads();
}
constexpr int NWAVES = 8, NTHREADS = 512;
constexpr int DM = 1024, SEQ = 4096, NB = 4, MP = NB * SEQ, SB = 32, ST = 4, MS = SB * ST, MREAL = MP + MS, MROWS = 16640;
constexpr int DFF = 2816, NIN = 2 * DFF, QW = 4608, AW = 512, DV = 3072, UVW = 6144;
constexpr float RMS_EPS = 1e-6f, LN_EPS = 1e-5f;
constexpr size_t O_Y = 0, O_YS = 16777216, O_KV128P = 16908288, O_KV512P = 17956864, O_KV2048P = 22151168, O_KV128S = 38928384, O_KV512S = 39190528, O_KV2048S = 39452672, O_VC = 39714816, O_END = 40501248;
constexpr size_t MiB = 1u << 20;
constexpr size_t WS_CTL = 0, CTL_ZERO_BYTES = 1 * MiB;
constexpr size_t SZ_WIN = (size_t)NIN * DM * 2, SZ_WOUT = (size_t)DM * DFF * 2, SZ_WQKV = (size_t)QW * DM * 2, SZ_WOA = (size_t)DM * AW * 2, SZ_WUV = (size_t)UVW * DM * 2, SZ_WOB = (size_t)DM * DV * 2;
constexpr size_t WS_WIN1 = 1 * MiB, WS_WOUT1 = WS_WIN1 + 4 * SZ_WIN, WS_WIN2 = WS_WOUT1 + 4 * SZ_WOUT, WS_WOUT2 = WS_WIN2 + 4 * SZ_WIN;
constexpr size_t WS_WQKV = WS_WOUT2 + 4 * SZ_WOUT, WS_WOA = WS_WQKV + 2 * SZ_WQKV, WS_WUV = WS_WOA + 2 * SZ_WOA, WS_WOB = WS_WUV + 2 * SZ_WUV;
constexpr size_t WS_X = WS_WOB + 2 * SZ_WOB;
constexpr size_t WS_XB = WS_X + (size_t)MROWS * DM * 4;
constexpr size_t WS_SS = WS_XB + (size_t)MROWS * DM * 2;
constexpr size_t WS_BIG = WS_SS + (size_t)MROWS * 16 * 4;
constexpr size_t WS_YZ = WS_BIG + (size_t)MROWS * UVW * 2;
constexpr size_t WS_WSB = WS_YZ + (size_t)MROWS * DV * 2;
constexpr size_t WS_VS = WS_WSB + (size_t)2 * 8 * 128 * 128 * 2;
constexpr size_t WS_SSS = WS_VS + (size_t)MP * 48 * 2 * 4;
constexpr size_t WS_END = WS_SSS + (size_t)MS * 32 * 4;
static_assert(WS_WIN1 % 256 == 0 && WS_X % 256 == 0 && WS_XB % 256 == 0 && WS_SS % 256 == 0 && WS_BIG % 256 == 0 && WS_YZ % 256 == 0, "alignment");
constexpr int CW_TMO = 0, CW_BAR = 4096;
constexpr int RING_OFF = 0, RING_BYTES = 143360;
constexpr int LDSCTL_OFF = RING_BYTES, MISC_OFF = LDSCTL_OFF + 320;
constexpr int LDS_BYTES = 147456;
struct Args { const float* in[21]; float* out; unsigned char* ws; int ph_lo, ph_hi; };
static_assert(sizeof(Args) == 192, "Args layout");
#define LOCAL_IDS int tid_ = threadIdx.x; asm volatile("" : "+v"(tid_)); const int tid = tid_, lane = tid & 63, wave = __builtin_amdgcn_readfirstlane(tid >> 6); (void)tid; (void)lane; (void)wave
#define CAS __attribute__((address_space(4)))
__device__ __forceinline__ const CAS unsigned char* kargp() { const CAS unsigned char* kp = (const CAS unsigned char*)__builtin_amdgcn_kernarg_segment_ptr(); asm volatile("" : "+s"(kp)); return kp; }
__device__ __forceinline__ const float* kin(int i) { return *(const float* const CAS*)(kargp() + 8 * i); }
__device__ __forceinline__ float* kout() { return *(float* const CAS*)(kargp() + 168); }
__device__ __forceinline__ unsigned char* kws() { return *(unsigned char* const CAS*)(kargp() + 176); }
__device__ __forceinline__ int opq(int v) { asm volatile("" : "+s"(v)); return v; }
struct Frame {
    LAS unsigned char* lds; volatile LAS unsigned* MISC; gu32* ctl;
    int vcu, G;
};
__device__ __forceinline__ float wave_sum(float v) {
#pragma unroll
    for (int o = 1; o < 64; o <<= 1) v += __shfl_xor(v, o);
    return v;
}
__device__ __forceinline__ float wave_max(float v) {
#pragma unroll
    for (int o = 1; o < 64; o <<= 1) v = fmaxf(v, __shfl_xor(v, o));
    return v;
}
__device__ __forceinline__ float bf2f(unsigned short h) { return __builtin_bit_cast(float, (unsigned)h << 16); }
__device__ __forceinline__ float bflo(unsigned w) { return __builtin_bit_cast(float, w << 16); }
__device__ __forceinline__ float bfhi(unsigned w) { return __builtin_bit_cast(float, w & 0xffff0000u); }

struct P0Item { const float* src; const float* gk; bf16* dst; int N, K; };
__device__ __forceinline__ P0Item p0_decode(int it, unsigned char* ws) {
    constexpr int I_IN = 16 * 176, I_OUT = 44 * 32, I_QKV = 16 * 144, I_OA = 8 * 32, I_UV = 16 * 192, I_OB = 48 * 32;
    const float* W; const float* g = nullptr; bf16* WT; int K, N, mode = 0, r = it, item;
    if (r < 4 * I_IN) { const int i = r / I_IN; item = r % I_IN; W = kin(6) + (size_t)i * DM * NIN; K = DM; N = NIN; g = kin(5) + i * DM; WT = (bf16*)(ws + WS_WIN1 + i * SZ_WIN); mode = 1; }
    else if ((r -= 4 * I_IN) < 4 * I_OUT) { const int i = r / I_OUT; item = r % I_OUT; W = kin(7) + (size_t)i * DFF * DM; K = DFF; N = DM; WT = (bf16*)(ws + WS_WOUT1 + i * SZ_WOUT); }
    else if ((r -= 4 * I_OUT) < 4 * I_IN) { const int i = r / I_IN; item = r % I_IN; W = kin(10) + (size_t)i * DM * NIN; K = DM; N = NIN; g = kin(9) + i * DM; WT = (bf16*)(ws + WS_WIN2 + i * SZ_WIN); mode = 1; }
    else if ((r -= 4 * I_IN) < 4 * I_OUT) { const int i = r / I_OUT; item = r % I_OUT; W = kin(11) + (size_t)i * DFF * DM; K = DFF; N = DM; WT = (bf16*)(ws + WS_WOUT2 + i * SZ_WOUT); }
    else if ((r -= 4 * I_OUT) < 2 * I_QKV) { const int l = r / I_QKV; item = r % I_QKV; W = kin(12) + (size_t)l * DM * QW; K = DM; N = QW; g = kin(8) + (2 * l) * DM; WT = (bf16*)(ws + WS_WQKV + l * SZ_WQKV); }
    else if ((r -= 2 * I_QKV) < 2 * I_OA) { const int l = r / I_OA; item = r % I_OA; W = kin(13) + (size_t)l * AW * DM; K = AW; N = DM; WT = (bf16*)(ws + WS_WOA + l * SZ_WOA); }
    else if ((r -= 2 * I_OA) < 2 * I_UV) { const int l = r / I_UV; item = r % I_UV; W = kin(14) + (size_t)l * DM * UVW; K = DM; N = UVW; g = kin(8) + (2 * l + 1) * DM; WT = (bf16*)(ws + WS_WUV + l * SZ_WUV); }
    else { r -= 2 * I_UV; const int l = r / I_OB; item = r % I_OB; W = kin(19) + (size_t)l * DV * DM; K = DV; N = DM; WT = (bf16*)(ws + WS_WOB + l * SZ_WOB); }
    const int nblk = N / 32, kb = item / nblk, nb = item % nblk, k0 = 64 * kb, n0 = 32 * nb;
    int r0 = n0;
    if (mode == 1) { const int up = n0 >= DFF ? 1 : 0, j = n0 - up * DFF; r0 = 256 * (j >> 7) + 128 * up + (j & 127); }
    P0Item I; I.src = W + (size_t)k0 * N + n0; I.gk = g ? g + k0 : nullptr; I.dst = WT + (size_t)r0 * K + k0; I.N = N; I.K = K; return I;
}
__device__ __forceinline__ void p0_load(const P0Item& I, int lane, f32x4 (&v)[8], f32x4 (&gs)[2]) {
    const int rr = lane >> 3, c4 = lane & 7;
#pragma unroll
    for (int i = 0; i < 8; ++i) v[i] = *(const GAS f32x4*)(I.src + (size_t)(8 * i + rr) * I.N + 4 * c4);
    if (I.gk) { gs[0] = *(const GAS f32x4*)(I.gk + 8 * c4); gs[1] = *(const GAS f32x4*)(I.gk + 8 * c4 + 4); } else { gs[0] = (f32x4){1.f, 1.f, 1.f, 1.f}; gs[1] = gs[0]; }
}
__device__ __forceinline__ void p0_store(const P0Item& I, int lane, const f32x4 (&v)[8], const f32x4 (&gs)[2], LAS float* scr) {
    const int rr = lane >> 3, c4 = lane & 7;
#pragma unroll
    for (int i = 0; i < 8; ++i) { LAS float* d = scr + (8 * i + rr) * 33 + 4 * c4; d[0] = v[i].x; d[1] = v[i].y; d[2] = v[i].z; d[3] = v[i].w; }
    LDS_WAIT(); asm volatile("" ::: "memory");
    const int c = lane & 7;
#pragma unroll
    for (int j = 0; j < 4; ++j) { const int n = (lane >> 3) + 8 * j; const LAS float* s = scr + (8 * c) * 33 + n;
        v4u o; o.x = pk2(gs[0].x * s[0 * 33], gs[0].y * s[1 * 33]); o.y = pk2(gs[0].z * s[2 * 33], gs[0].w * s[3 * 33]); o.z = pk2(gs[1].x * s[4 * 33], gs[1].y * s[5 * 33]); o.w = pk2(gs[1].z * s[6 * 33], gs[1].w * s[7 * 33]);
        *(GAS v4u*)(I.dst + (size_t)n * I.K + 8 * c) = o; }
    LDS_WAIT(); asm volatile("" ::: "memory");
}
constexpr int CV_EVEN = 11008, CV_ODD = 13056, CV_PAIR = CV_EVEN + CV_ODD, CV_TOTAL = 2 * CV_PAIR;
constexpr int CV_PER = 52, CV_PRO = 2816;
__device__ __forceinline__ int cv_layer_end(int L) { return (L >> 1) * CV_PAIR + ((L & 1) ? CV_PAIR : CV_EVEN); }
__device__ __forceinline__ int seq_to_item(int seq) {
    const int pi = seq / CV_PAIR; int r = seq - pi * CV_PAIR; const int odd = r >= CV_EVEN ? 1 : 0; r -= odd * CV_EVEN; const int L = 2 * pi + odd;
    if (r < 2816) return L * 2816 + r; r -= 2816;
    if (r < 1408) return 11264 + L * 1408 + r; r -= 1408;
    if (!odd) { if (r < 2304) return 33792 + pi * 2304 + r; r -= 2304; if (r < 256) return 38400 + pi * 256 + r; r -= 256; }
    else { if (r < 3072) return 38912 + pi * 3072 + r; r -= 3072; if (r < 1536) return 45056 + pi * 1536 + r; r -= 1536; }
    if (r < 2816) return 16896 + L * 2816 + r; r -= 2816;
    return 28160 + L * 1408 + r;
}
__device__ __forceinline__ void convert_range(Frame& F, int seq0, int seq1, int step) {
    LOCAL_IDS;
    LAS float* scr = (LAS float*)(F.lds + RING_OFF + wave * 16384);
    unsigned char* ws = kws();
    for (int sq = seq0; sq < seq1; sq += 2 * step) {
        const bool two = sq + step < seq1;
        const P0Item A = p0_decode(seq_to_item(sq), ws); const P0Item B = p0_decode(seq_to_item(two ? sq + step : sq), ws);
        f32x4 va[8], vb[8]; f32x4 ga[2], gb[2];
        p0_load(A, lane, va, ga); p0_load(B, lane, vb, gb);
        asm volatile("" ::: "memory");
        p0_store(A, lane, va, ga, scr);
        if (two) p0_store(B, lane, vb, gb, scr);
    }
}
__device__ __forceinline__ int convert_slack(Frame& F, int nwg, int base) {
    const int G = F.G, rounds = (nwg + G - 1) / G, c0 = nwg - (rounds - 1) * G, c = (int)blockIdx.x;
    if (c >= c0 && base < CV_TOTAL) { const int wave = __builtin_amdgcn_readfirstlane((int)threadIdx.x >> 6); const int s0 = base + (c - c0) * CV_PER; int s1 = s0 + CV_PER; s1 = s1 < CV_TOTAL ? s1 : CV_TOTAL;
        convert_range(F, s0 + wave, s1, NWAVES); }
    const int nb = base + (G - c0) * CV_PER; return nb < CV_TOTAL ? nb : CV_TOTAL;
}
__device__ __forceinline__ int cv_need(int L, int k) {
    const int start = (L >> 1) * CV_PAIR + ((L & 1) ? CV_EVEN : 0), odd = L & 1;
    const int proj = 4224 + (odd ? 3072 : 2304), outp = proj + (odd ? 1536 : 256);
    const int off = k == 0 ? 2816 : (k == 1 ? 4224 : (k <= 4 ? proj : (k == 5 ? outp : (k == 6 ? outp + 2816 : outp + 4224))));
    return start + off;
}
__device__ __forceinline__ int cv_guard(Frame& F, int base, int need) {
    if (base < need) { __syncthreads();
        const int wave_ = __builtin_amdgcn_readfirstlane((int)threadIdx.x >> 6); convert_range(F, base + F.vcu * NWAVES + wave_, need, F.G * NWAVES); return need; }
    return base;
}
__device__ __forceinline__ void p0_prologue(Frame& F, const Args& a) {
    LOCAL_IDS;
    const int gw = F.vcu * NWAVES + wave, NGW = F.G * NWAVES;
    unsigned char* ws = kws();
    convert_range(F, gw, CV_PRO, NGW);
    { bf16* Wsb = (bf16*)(ws + WS_WSB); for (int e = F.vcu * NTHREADS + tid; e < 2 * 8 * 128 * 128; e += F.G * NTHREADS) { const int t = (e >> 7) & 127, s = e & 127; Wsb[e] = s <= t ? (bf16)f2bf(kin(17)[e]) : (bf16)0; } }
    bf16* XB = (bf16*)(ws + WS_XB); float* SS = (float*)(ws + WS_SS);
    bf16* YZ = (bf16*)(ws + WS_YZ);
    for (int m0 = gw; m0 < MROWS; m0 += 2 * NGW) {
        f32x4 v[2][4];
#pragma unroll
        for (int k = 0; k < 2; ++k) { const int m = m0 + k * NGW; const float* src = m < MP ? kin(0) + (size_t)m * DM : (m < MREAL ? kin(1) + (size_t)(m - MP) * DM : nullptr);
#pragma unroll
            for (int j = 0; j < 4; ++j) v[k][j] = src ? ((const GAS f32x4*)src)[lane + 64 * j] : (f32x4){0.f, 0.f, 0.f, 0.f}; }
        asm volatile("" ::: "memory");
#pragma unroll
        for (int k = 0; k < 2; ++k) { const int m = m0 + k * NGW; if (m < MROWS) { float s = 0.f;
#pragma unroll
            for (int j = 0; j < 4; ++j) { const unsigned w0 = pk2(v[k][j].x, v[k][j].y), w1 = pk2(v[k][j].z, v[k][j].w);
                ((GAS unsigned long long*)(XB + (size_t)m * DM))[lane + 64 * j] = (unsigned long long)w0 | ((unsigned long long)w1 << 32);
                s += (bflo(w0) * bflo(w0) + bfhi(w0) * bfhi(w0)) + (bflo(w1) * bflo(w1) + bfhi(w1) * bfhi(w1)); }
            s = wave_sum(s);
            if (lane < 16) SS[(size_t)m * 16 + lane] = lane == 0 ? s : 0.f;
            if (m >= MP && m < MREAL && lane < 32) ((float*)(ws + WS_SSS))[(size_t)(m - MP) * 32 + lane] = lane == 0 ? s : 0.f;
            if (m >= MREAL) { for (int j = lane; j < DV / 8; j += 64) ((GAS v4u*)(YZ + (size_t)m * DV))[j] = (v4u){0u, 0u, 0u, 0u}; } } }
    }
}

__device__ __forceinline__ float dot64_bf16(const unsigned (&q)[32], const bf16* kp) {
    float s = 0.f;
#pragma unroll
    for (int c = 0; c < 8; ++c) { const v4u kx = *(const GAS v4u*)(kp + 8 * c);
        s += bflo(q[4 * c + 0]) * bflo(kx.x) + bfhi(q[4 * c + 0]) * bfhi(kx.x); s += bflo(q[4 * c + 1]) * bflo(kx.y) + bfhi(q[4 * c + 1]) * bfhi(kx.y);
        s += bflo(q[4 * c + 2]) * bflo(kx.z) + bfhi(q[4 * c + 2]) * bfhi(kx.z); s += bflo(q[4 * c + 3]) * bflo(kx.w) + bfhi(q[4 * c + 3]) * bfhi(kx.w); }
    return s;
}
__device__ __forceinline__ float dot64_f32(const unsigned (&q)[32], const float* kp) {
    float s = 0.f;
#pragma unroll
    for (int c = 0; c < 16; ++c) { const f32x4 kx = *(const GAS f32x4*)(kp + 4 * c);
        s += bflo(q[2 * c]) * kx.x + bfhi(q[2 * c]) * kx.y; s += bflo(q[2 * c + 1]) * kx.z + bfhi(q[2 * c + 1]) * kx.w; }
    return s;
}
__device__ __forceinline__ void load_q(unsigned (&q)[32], const bf16* qp) {
#pragma unroll
    for (int c = 0; c < 8; ++c) { const v4u x = *(const GAS v4u*)(qp + 8 * c); q[4 * c] = x.x; q[4 * c + 1] = x.y; q[4 * c + 2] = x.z; q[4 * c + 3] = x.w; }
}
__device__ __forceinline__ void attn_prompt_v1(Frame& F, const bf16* QKV, bf16* Y) {
    LOCAL_IDS;
    const float NEG = -INFINITY;
    for (int it = F.vcu; it < 256 * 8; it += F.G) {
        const int rb = it >> 3, h = it & 7;
        for (int i = 0; i < 8; ++i) {
            const int r = rb * 64 + wave * 8 + i, t = r & (SEQ - 1);
            float og[3], lse[3];
#pragma unroll
            for (int g = 0; g < 3; ++g) {
                const int sh = 2 * g, m = t >> sh, nk = (m < 128 ? m : 128) + 1;
                const int qcol = g * 512 + h * 64;
                unsigned q[32]; load_q(q, QKV + (size_t)r * QW + qcol);
                const bf16* kb = QKV + (size_t)r * QW + 1536 + qcol; const bf16* vb = QKV + (size_t)r * QW + 3072 + qcol;
                const size_t jstride = (size_t)QW << sh;
                float s0 = NEG, s1 = NEG, s2 = NEG;
                if (lane < nk) s0 = 0.125f * dot64_bf16(q, kb - (size_t)lane * jstride);
                if (lane + 64 < nk) s1 = 0.125f * dot64_bf16(q, kb - (size_t)(lane + 64) * jstride);
                if (nk > 128) { if (lane == 0) s2 = 0.125f * dot64_bf16(q, kb - (size_t)128 * jstride); }
                const float mx = wave_max(fmaxf(fmaxf(s0, s1), s2));
                const float p0 = __expf(s0 - mx), p1 = __expf(s1 - mx), p2 = __expf(s2 - mx);
                const float l = wave_sum(p0 + p1 + p2);
                float o = 0.f;
                const int n0 = nk < 64 ? nk : 64;
                for (int j = 0; j < n0; ++j) o += __shfl(p0, j) * bf2f(vb[lane - (ptrdiff_t)((size_t)j * jstride)]);
                const int n1 = nk - 64 < 64 ? nk - 64 : 64;
                for (int j = 0; j < n1; ++j) o += __shfl(p1, j) * bf2f(vb[lane - (ptrdiff_t)((size_t)(j + 64) * jstride)]);
                if (nk > 128) o += __shfl(p2, 0) * bf2f(vb[lane - (ptrdiff_t)((size_t)128 * jstride)]);
                og[g] = o / l; lse[g] = mx + __logf(l);
            }
            const float M = fmaxf(fmaxf(lse[0], lse[1]), lse[2]);
            const float w0 = __expf(lse[0] - M), w1 = __expf(lse[1] - M), w2 = __expf(lse[2] - M);
            const float y = (w0 * og[0] + w1 * og[1] + w2 * og[2]) / (w0 + w1 + w2);
            Y[(size_t)r * AW + h * 64 + lane] = (bf16)f2bf(y);
        }
    }
}
__device__ __forceinline__ void attn_sample_v1(Frame& F, const Args& a, const bf16* QKV, bf16* Y, int li) {
    LOCAL_IDS;
    const int gw = F.vcu * NWAVES + wave, NGW = F.G * NWAVES;
    for (int task = gw; task < MS * 8; task += NGW) {
        const int sr = task >> 3, h = task & 7, sb = sr >> 2, t = sr & 3, r = MP + sr;
        float og[3], lse[3];
#pragma unroll
        for (int g = 0; g < 3; ++g) {
            const int sh = 2 * g, dil = 1 << sh, L = 128 << sh;
            const float* cache = kin(2 + g) + ((size_t)(li * SB + sb) * L) * 1024;
            const int qcol = g * 512 + h * 64;
            unsigned q[32]; load_q(q, QKV + (size_t)r * QW + qcol);
            float s[3];
#pragma unroll
            for (int rd = 0; rd < 3; ++rd) { const int j = lane + 64 * rd; s[rd] = -INFINITY;
                if (j <= 128) { const int idx = L + t - dil * j;
                    if (idx >= L) s[rd] = 0.125f * dot64_bf16(q, QKV + (size_t)(MP + sb * 4 + (idx - L)) * QW + 1536 + qcol);
                    else s[rd] = 0.125f * dot64_f32(q, cache + (size_t)idx * 1024 + h * 64); } }
            const float mx = wave_max(fmaxf(fmaxf(s[0], s[1]), s[2]));
            const float p0 = __expf(s[0] - mx), p1 = __expf(s[1] - mx), p2 = __expf(s[2] - mx);
            const float l = wave_sum(p0 + p1 + p2);
            float o = 0.f;
            for (int j = 0; j <= 128; ++j) { const float pj = j < 64 ? __shfl(p0, j) : (j < 128 ? __shfl(p1, j - 64) : __shfl(p2, 0));
                const int idx = L + t - dil * j;
                const float v = idx >= L ? bf2f(QKV[(size_t)(MP + sb * 4 + (idx - L)) * QW + 3072 + qcol + lane]) : cache[(size_t)idx * 1024 + 512 + h * 64 + lane];
                o += pj * v; }
            og[g] = o / l; lse[g] = mx + __logf(l);
        }
        const float M = fmaxf(fmaxf(lse[0], lse[1]), lse[2]);
        const float w0 = __expf(lse[0] - M), w1 = __expf(lse[1] - M), w2 = __expf(lse[2] - M);
        const float y = (w0 * og[0] + w1 * og[1] + w2 * og[2]) / (w0 + w1 + w2);
        Y[(size_t)r * AW + h * 64 + lane] = (bf16)f2bf(y);
    }
}

__device__ __forceinline__ void row_stats_bf16(const bf16* vp, int lane, float& mean, float& rstd) {
    float s = 0.f, q = 0.f; v4u xs[6];
#pragma unroll
    for (int j = 0; j < 6; ++j) xs[j] = ((const GAS v4u*)vp)[lane + 64 * j];
    asm volatile("" ::: "memory");
#pragma unroll
    for (int j = 0; j < 6; ++j) { const v4u x = xs[j]; const unsigned w[4] = {x.x, x.y, x.z, x.w};
#pragma unroll
        for (int e = 0; e < 4; ++e) { const float a = bflo(w[e]), b = bfhi(w[e]); s += a + b; q += a * a + b * b; } }
    s = wave_sum(s); q = wave_sum(q);
    mean = s * (1.0f / DV); const float var = q * (1.0f / DV) - mean * mean; rstd = __builtin_amdgcn_rsqf(fmaxf(var, 0.f) + LN_EPS);
}
__device__ __forceinline__ void spatial_prompt_v1(Frame& F, const Args& a, const bf16* UV, bf16* Z, int li) {
    LOCAL_IDS;
    LAS float* Wl = (LAS float*)(F.lds + RING_OFF);
    LAS float* st = (LAS float*)(F.lds + RING_OFF + 65536);
    const float* lng = kin(15) + li * DV; const float* lnb = kin(16) + li * DV;
    for (int it = F.vcu; it < 128 * 8; it += F.G) {
        const int cidx = it >> 3, gg = it & 7, row0 = cidx * 128;
        const float* wsp = kin(17) + (size_t)(li * 8 + gg) * 128 * 128; const float* bsp = kin(18) + (li * 8 + gg) * 128;
        __syncthreads();
        for (int i = 0; i < 16; ++i) { const int rr = wave * 16 + i; float mean, rstd; row_stats_bf16(UV + (size_t)(row0 + rr) * UVW + DV, lane, mean, rstd);
            if (lane == 0) { st[2 * rr] = mean; st[2 * rr + 1] = rstd; } }
        for (int e = tid; e < 128 * 128; e += NTHREADS) { const int t = e >> 7, s = e & 127; Wl[s * 128 + t] = s <= t ? wsp[e] : 0.f; }
        __syncthreads();
        if (tid < 384) {
            const int ch = gg * 384 + tid; const float gain = lng[ch], bias = lnb[ch];
            float acc[128];
#pragma unroll
            for (int t = 0; t < 128; ++t) acc[t] = 0.f;
#pragma unroll 1
            for (int s = 0; s < 128; ++s) {
                const float vn = (bf2f(UV[(size_t)(row0 + s) * UVW + DV + ch]) - st[2 * s]) * st[2 * s + 1] * gain + bias;
#pragma unroll
                for (int t4 = 0; t4 < 32; ++t4) { const f32x4 w = *(const LAS f32x4*)(Wl + s * 128 + 4 * t4);
                    acc[4 * t4] += w.x * vn; acc[4 * t4 + 1] += w.y * vn; acc[4 * t4 + 2] += w.z * vn; acc[4 * t4 + 3] += w.w * vn; }
            }
#pragma unroll
            for (int t = 0; t < 128; ++t) { const float mixed = acc[t] + bsp[t]; const float u = bf2f(UV[(size_t)(row0 + t) * UVW + ch]);
                Z[(size_t)(row0 + t) * DV + ch] = (bf16)f2bf(u * mixed); }
        }
    }
}
__device__ __forceinline__ void spatial_sample_v1(Frame& F, const Args& a, const bf16* UV, bf16* Z, int li) {
    LOCAL_IDS;
    LAS float* st = (LAS float*)(F.lds + RING_OFF + 65536 + 2048);
    const float* lng = kin(15) + li * DV; const float* lnb = kin(16) + li * DV;
    for (int it = F.vcu; it < SB * 6; it += F.G) {
        const int sb = it / 6, cb = it - sb * 6, row0 = MP + sb * 4;
        __syncthreads();
        if (wave < 4) { float mean, rstd; row_stats_bf16(UV + (size_t)(row0 + wave) * UVW + DV, lane, mean, rstd); if (lane == 0) { st[2 * wave] = mean; st[2 * wave + 1] = rstd; } }
        __syncthreads();
        const int ch = cb * NTHREADS + tid, g = ch / 384;
        const float* wsp = kin(17) + (size_t)(li * 8 + g) * 128 * 128; const float* bsp = kin(18) + (li * 8 + g) * 128;
        const float gain = lng[ch], bias = lnb[ch];
        float vr[4], ur[4], bs[4], w[4][4];
#pragma unroll
        for (int t = 0; t < 4; ++t) { vr[t] = bf2f(UV[(size_t)(row0 + t) * UVW + DV + ch]); ur[t] = bf2f(UV[(size_t)(row0 + t) * UVW + ch]); bs[t] = bsp[t];
#pragma unroll
            for (int s = 0; s < 4; ++s) w[t][s] = s <= t ? wsp[t * 128 + s] : 0.f; }
        asm volatile("" ::: "memory");
        float vn[4];
#pragma unroll
        for (int t = 0; t < 4; ++t) { vn[t] = (vr[t] - st[2 * t]) * st[2 * t + 1] * gain + bias;
            kout()[O_VC + ((size_t)(li * SB + sb) * 4 + t) * DV + ch] = vn[t]; }
#pragma unroll
        for (int t = 0; t < 4; ++t) { float mixed = bs[t];
#pragma unroll
            for (int s = 0; s < 4; ++s) mixed += w[t][s] * vn[s];
            Z[(size_t)(row0 + t) * DV + ch] = (bf16)f2bf(ur[t] * mixed); }
    }
}
__device__ __forceinline__ float dpp16_sum(float v) {
    v += __builtin_bit_cast(float, __builtin_amdgcn_update_dpp(0, __builtin_bit_cast(int, v), 0xB1, 0xF, 0xF, false));
    v += __builtin_bit_cast(float, __builtin_amdgcn_update_dpp(0, __builtin_bit_cast(int, v), 0x4E, 0xF, 0xF, false));
    v += __builtin_bit_cast(float, __builtin_amdgcn_update_dpp(0, __builtin_bit_cast(int, v), 0x141, 0xF, 0xF, false));
    v += __builtin_bit_cast(float, __builtin_amdgcn_update_dpp(0, __builtin_bit_cast(int, v), 0x140, 0xF, 0xF, false));
    return v;
}
__device__ __forceinline__ void final_norm(Frame& F, const Args& a) {
    LOCAL_IDS;
    const int gw = F.vcu * NWAVES + wave, NGW = F.G * NWAVES;
    const bf16* XB = (const bf16*)(kws() + WS_XB); const float* SS = (const float*)(kws() + WS_SS); const float* gf = kin(20);
    f32x4 g[4];
#pragma unroll
    for (int j = 0; j < 4; ++j) g[j] = ((const GAS f32x4*)gf)[lane + 64 * j];
    for (int m0 = gw; m0 < MREAL; m0 += 2 * NGW) {
        unsigned long long xw[2][4]; float rs[2];
#pragma unroll
        for (int k = 0; k < 2; ++k) { int m = m0 + k * NGW; m = m < MREAL ? m : MREAL - 1;
            if (m < MP) rs[k] = SS[(size_t)m * 16 + (lane & 15)];     else rs[k] = pg8::any_rstd(SS, (const float*)(kws() + WS_SSS), m);
#pragma unroll
            for (int j = 0; j < 4; ++j) xw[k][j] = ((const GAS unsigned long long*)(XB + (size_t)m * DM))[lane + 64 * j]; }
        asm volatile("" ::: "memory");
#pragma unroll
        for (int k = 0; k < 2; ++k) { const int m = m0 + k * NGW; if (m < MREAL) {
            if (m < MP) rs[k] = __builtin_amdgcn_rsqf(dpp16_sum(rs[k]) * (1.0f / 1024.0f) + 1e-6f);
            float* dst = m < MP ? kout() + O_Y + (size_t)m * DM : kout() + O_YS + (size_t)(m - MP) * DM;
#pragma unroll
            for (int j = 0; j < 4; ++j) { const unsigned w0 = (unsigned)xw[k][j], w1 = (unsigned)(xw[k][j] >> 32);
                ((GAS f32x4*)dst)[lane + 64 * j] = (f32x4){bflo(w0) * rs[k] * g[j].x, bfhi(w0) * rs[k] * g[j].y, bflo(w1) * rs[k] * g[j].z, bfhi(w1) * rs[k] * g[j].w}; } } }
    }
}
typedef float f32x16 __attribute__((ext_vector_type(16)));
typedef short s16x4 __attribute__((ext_vector_type(4)));
typedef short v4i16_t __attribute__((ext_vector_type(4)));
typedef unsigned u32x2 __attribute__((ext_vector_type(2)));
typedef unsigned u32x4 __attribute__((ext_vector_type(4)));
__device__ __forceinline__ unsigned cvtpk(float lo, float hi) { unsigned r; asm volatile("v_cvt_pk_bf16_f32 %0, %1, %2" : "=v"(r) : "v"(lo), "v"(hi)); return r; }
__device__ __forceinline__ s16x4 vtr(const LAS unsigned char* p) { return __builtin_bit_cast(s16x4, __builtin_amdgcn_ds_read_tr16_b64_v4i16((LAS v4i16_t*)p)); }
struct AttnTask { const bf16* base; int m0, sh, r, b, g, kt_lo; };
__device__ __forceinline__ AttnTask attn_task(int u, int h, const bf16* QKV) {
    AttnTask T; const int tq = u & 127, gb = u >> 7; T.g = gb % 3; T.b = gb / 3; T.sh = 2 * T.g;
    const int nq = 128 >> T.sh; T.r = tq >> (7 - T.sh); T.m0 = (tq & (nq - 1)) * 32;
    T.base = QKV + ((size_t)((T.b * 3 + T.g) * 8 + h) * 4096 + (size_t)T.r * (4096 >> T.sh)) * 64;
    T.kt_lo = T.m0 >= 128 ? 0 : 4 - (T.m0 >> 5); return T;
}
__device__ __forceinline__ void attn_load_qk(const AttnTask& T, int jq, int hh, bf16x8 (&qf)[4], bf16x8 (&kf)[5][4]) {
    constexpr size_t SECSTR = (size_t)4 * 3 * 8 * 4096 * 64;
    { const bf16* qp = T.base + (size_t)(T.m0 + jq) * 64 + 32 * hh;
#pragma unroll
      for (int s = 0; s < 4; ++s) qf[s] = *(const GAS bf16x8*)(qp + 8 * s); }
#pragma unroll
    for (int kt = 0; kt < 5; ++kt) { int kpos = T.m0 - 128 + 32 * kt + jq; kpos = kpos < 0 ? 0 : kpos;
        const bf16* kp = T.base + SECSTR + (size_t)kpos * 64 + 32 * hh;
#pragma unroll
        for (int s = 0; s < 4; ++s) kf[kt][s] = *(const GAS bf16x8*)(kp + 8 * s); }
}
__device__ __forceinline__ void attn_load_v(const AttnTask& T, int kt, int lane, v4u (&vx)[4]) {
    constexpr size_t SECSTR = (size_t)4 * 3 * 8 * 4096 * 64;
#pragma unroll
    for (int it = 0; it < 4; ++it) { const int idx = it * 64 + lane, key = idx >> 3, cp = idx & 7; int kpos = T.m0 - 128 + 32 * kt + key; kpos = kpos < 0 ? 0 : kpos;
        vx[it] = *(const GAS v4u*)(T.base + 2 * SECSTR + (size_t)kpos * 64 + cp * 8); }
}
__device__ __forceinline__ void attn_pv_tile(LAS unsigned char* vb, int lane, int trb, const v4u (&vx)[4], const u32x4 (&pw)[2], f32x16& O0, f32x16& O1) {
#pragma unroll
    for (int it = 0; it < 4; ++it) { const int idx = it * 64 + lane, key = idx >> 3, cp = idx & 7;
        *(LAS v4u*)(vb + (cp >> 2) * 2048 + key * 64 + (cp & 3) * 16) = vx[it]; }
#pragma unroll
    for (int sp = 0; sp < 2; ++sp) { const bf16x8 pf = __builtin_bit_cast(bf16x8, pw[sp]);
        { const s16x4 lo = vtr(vb + sp * 1024 + trb), hi = vtr(vb + sp * 1024 + 512 + trb);
          const bf16x8 vf = (bf16x8){lo[0], lo[1], lo[2], lo[3], hi[0], hi[1], hi[2], hi[3]};
          O0 = __builtin_amdgcn_mfma_f32_32x32x16_bf16(vf, pf, O0, 0, 0, 0); }
        { const s16x4 lo = vtr(vb + 2048 + sp * 1024 + trb), hi = vtr(vb + 2048 + sp * 1024 + 512 + trb);
          const bf16x8 vf = (bf16x8){lo[0], lo[1], lo[2], lo[3], hi[0], hi[1], hi[2], hi[3]};
          O1 = __builtin_amdgcn_mfma_f32_32x32x16_bf16(vf, pf, O1, 0, 0, 0); } }
}
__device__ __forceinline__ void attn_prompt_mfma(Frame& F, const bf16* QKV, bf16* OG, float* LSE) {
    LOCAL_IDS;
    const int jq = lane & 31, hh = lane >> 5, h = wave;
    LAS unsigned char* vst = F.lds + RING_OFF + wave * 8192;
    const int trb = ((lane >> 4) & 1) * 32 + (lane & 3) * 8 + (4 * hh + ((lane & 15) >> 2)) * 64;
    const float NEG = -INFINITY, c = 0.125f * 1.4426950408889634f;
    int u = F.vcu;
    if (u >= 1536) return;
    AttnTask T = attn_task(u, h, QKV);
    bf16x8 qf[4], kf[5][4];
    attn_load_qk(T, jq, hh, qf, kf);
    for (;;) {
        f32x16 S[5];
#pragma unroll
        for (int kt = 0; kt < 5; ++kt) {
#pragma unroll
            for (int e = 0; e < 16; ++e) S[kt][e] = 0.f;
#pragma unroll
            for (int s = 0; s < 4; ++s) S[kt] = __builtin_amdgcn_mfma_f32_32x32x16_bf16(kf[kt][s], qf[s], S[kt], 0, 0, 0);
        }
        v4u va[4], vb4[4];
        attn_load_v(T, 0, lane, va); attn_load_v(T, 1, lane, vb4);
#pragma unroll
        for (int e = 0; e < 16; ++e) { const int i = (e & 3) + 8 * (e >> 2) + 4 * hh; if (i < jq) S[0][e] = NEG; if (i > jq) S[4][e] = NEG; }
#pragma unroll
        for (int kt = 0; kt < 4; ++kt) { const bool dead = kt < T.kt_lo;
#pragma unroll
            for (int e = 0; e < 16; ++e) S[kt][e] = dead ? NEG : S[kt][e]; }
        float mx = NEG;
#pragma unroll
        for (int kt = 0; kt < 5; ++kt)
#pragma unroll
            for (int e = 0; e < 16; ++e) mx = fmaxf(mx, S[kt][e]);
        mx = fmaxf(mx, __shfl_xor(mx, 32));
        float l = 0.f; u32x4 pw[5][2]; const float nmc = -mx * c;
#pragma unroll
        for (int kt = 0; kt < 5; ++kt) {
#pragma unroll
            for (int e = 0; e < 16; ++e) { const float pv = __builtin_amdgcn_exp2f(__builtin_fmaf(S[kt][e], c, nmc)); S[kt][e] = pv; l += pv; }
#pragma unroll
            for (int sp = 0; sp < 2; ++sp) { pw[kt][sp].x = cvtpk(S[kt][8 * sp + 0], S[kt][8 * sp + 1]); pw[kt][sp].y = cvtpk(S[kt][8 * sp + 2], S[kt][8 * sp + 3]); pw[kt][sp].z = cvtpk(S[kt][8 * sp + 4], S[kt][8 * sp + 5]); pw[kt][sp].w = cvtpk(S[kt][8 * sp + 6], S[kt][8 * sp + 7]); } }
        l += __shfl_xor(l, 32);
        const int un = u + F.G; const bool more = un < 1536;
        const AttnTask Tc = T;
        if (more) { T = attn_task(un, h, QKV); attn_load_qk(T, jq, hh, qf, kf); }
        f32x16 O0, O1;
#pragma unroll
        for (int e = 0; e < 16; ++e) { O0[e] = 0.f; O1[e] = 0.f; }
        attn_pv_tile(vst, lane, trb, va, pw[0], O0, O1);          attn_load_v(Tc, 2, lane, va);
        attn_pv_tile(vst + 4096, lane, trb, vb4, pw[1], O0, O1);  attn_load_v(Tc, 3, lane, vb4);
        attn_pv_tile(vst, lane, trb, va, pw[2], O0, O1);          attn_load_v(Tc, 4, lane, va);
        attn_pv_tile(vst + 4096, lane, trb, vb4, pw[3], O0, O1);
        attn_pv_tile(vst, lane, trb, va, pw[4], O0, O1);
        const float inv = 1.0f / l;
        const int row = Tc.b * SEQ + ((Tc.m0 + jq) << Tc.sh) + Tc.r;
        bf16* op = OG + ((size_t)Tc.g * MREAL + row) * AW + h * 64 + 4 * hh;
#pragma unroll
        for (int a4 = 0; a4 < 4; ++a4) {
            u32x2 w0; w0.x = cvtpk(O0[4 * a4] * inv, O0[4 * a4 + 1] * inv); w0.y = cvtpk(O0[4 * a4 + 2] * inv, O0[4 * a4 + 3] * inv); *(GAS u32x2*)(op + 8 * a4) = w0;
            u32x2 w1; w1.x = cvtpk(O1[4 * a4] * inv, O1[4 * a4 + 1] * inv); w1.y = cvtpk(O1[4 * a4 + 2] * inv, O1[4 * a4 + 3] * inv); *(GAS u32x2*)(op + 32 + 8 * a4) = w1; }
        if (hh == 0) LSE[((size_t)Tc.g * MREAL + row) * 8 + h] = mx * 0.125f + __logf(l);
        if (!more) break;
        u = un;
    }
}
__device__ __forceinline__ void attn_merge(Frame& F, const bf16* OG, const bf16* OGS, const float* LSE, bf16* Y) {
    LOCAL_IDS;
    constexpr int NIT = MREAL * 64, UNR = 4;
    const int stride = F.G * NTHREADS;
    for (int base = F.vcu * NTHREADS + tid; base < NIT; base += UNR * stride) {
        v4u x0[UNR], x1[UNR], x2[UNR]; float l0[UNR], l1[UNR], l2[UNR];
#pragma unroll
        for (int k = 0; k < UNR; ++k) { int idx = base + k * stride; idx = idx < NIT ? idx : NIT - 1; const int row = idx >> 6, c8 = idx & 63, h = c8 >> 3, pc = c8 & 7;
            { const f32x4 lv = *(const GAS f32x4*)(LSE + ((size_t)row * 8 + h) * 4); l0[k] = lv.x; l1[k] = lv.y; l2[k] = lv.z; }
            const bf16 *p0, *p1, *p2;
            if (row < MP) { const int b = row >> 12, t = row & 4095;
                p0 = OG + ((size_t)((0 * 4 + b) * 8 + h) * 4096 + t) * 64 + pc * 8;
                p1 = OG + ((size_t)((1 * 4 + b) * 8 + h) * 4096 + ((t & 3) << 10) + (t >> 2)) * 64 + pc * 8;
                p2 = OG + ((size_t)((2 * 4 + b) * 8 + h) * 4096 + ((t & 15) << 8) + (t >> 4)) * 64 + pc * 8;
            } else { const int sr = row - MP; p0 = OGS + (size_t)sr * AW + c8 * 8; p1 = OGS + ((size_t)MS + sr) * AW + c8 * 8; p2 = OGS + ((size_t)2 * MS + sr) * AW + c8 * 8; }
            x0[k] = *(const GAS v4u*)p0; x1[k] = *(const GAS v4u*)p1; x2[k] = *(const GAS v4u*)p2; }
        asm volatile("" ::: "memory");
#pragma unroll
        for (int k = 0; k < UNR; ++k) { const int idx = base + k * stride; if (idx < NIT) { const int row = idx >> 6, c8 = idx & 63;
            const float M = fmaxf(fmaxf(l0[k], l1[k]), l2[k]);
            float w0 = __expf(l0[k] - M), w1 = __expf(l1[k] - M), w2 = __expf(l2[k] - M); const float inv = 1.0f / (w0 + w1 + w2); w0 *= inv; w1 *= inv; w2 *= inv;
            const unsigned a0[4] = {x0[k].x, x0[k].y, x0[k].z, x0[k].w}, a1[4] = {x1[k].x, x1[k].y, x1[k].z, x1[k].w}, a2[4] = {x2[k].x, x2[k].y, x2[k].z, x2[k].w}; unsigned o[4];
#pragma unroll
            for (int e = 0; e < 4; ++e) o[e] = pk2(w0 * bflo(a0[e]) + w1 * bflo(a1[e]) + w2 * bflo(a2[e]), w0 * bfhi(a0[e]) + w1 * bfhi(a1[e]) + w2 * bfhi(a2[e]));
            *(GAS v4u*)(Y + (size_t)row * AW + c8 * 8) = (v4u){o[0], o[1], o[2], o[3]}; } }
    }
}
__device__ __forceinline__ void attn_core(const AttnTask& T, int jq, int hh, int lane, LAS unsigned char* vst, int trb, f32x16& O0, f32x16& O1, float& l, float& mx) {
    const float NEG = -INFINITY, c = 0.125f * 1.4426950408889634f;
    bf16x8 qf[4], kf[5][4];
    attn_load_qk(T, jq, hh, qf, kf);
    f32x16 S[5];
#pragma unroll
    for (int kt = 0; kt < 5; ++kt) {
#pragma unroll
        for (int e = 0; e < 16; ++e) S[kt][e] = 0.f;
#pragma unroll
        for (int s = 0; s < 4; ++s) S[kt] = __builtin_amdgcn_mfma_f32_32x32x16_bf16(kf[kt][s], qf[s], S[kt], 0, 0, 0);
    }
    v4u va[4], vb4[4];
    attn_load_v(T, 0, lane, va); attn_load_v(T, 1, lane, vb4);
#pragma unroll
    for (int e = 0; e < 16; ++e) { const int i = (e & 3) + 8 * (e >> 2) + 4 * hh; if (i < jq) S[0][e] = NEG; if (i > jq) S[4][e] = NEG; }
#pragma unroll
    for (int kt = 0; kt < 4; ++kt) { const bool dead = kt < T.kt_lo;
#pragma unroll
        for (int e = 0; e < 16; ++e) S[kt][e] = dead ? NEG : S[kt][e]; }
    mx = NEG;
#pragma unroll
    for (int kt = 0; kt < 5; ++kt)
#pragma unroll
        for (int e = 0; e < 16; ++e) mx = fmaxf(mx, S[kt][e]);
    mx = fmaxf(mx, __shfl_xor(mx, 32));
    l = 0.f; u32x4 pw[5][2];
#pragma unroll
    for (int kt = 0; kt < 5; ++kt) {
#pragma unroll
        for (int e = 0; e < 16; ++e) { const float pv = __builtin_amdgcn_exp2f((S[kt][e] - mx) * c); S[kt][e] = pv; l += pv; }
#pragma unroll
        for (int sp = 0; sp < 2; ++sp) { pw[kt][sp].x = cvtpk(S[kt][8 * sp + 0], S[kt][8 * sp + 1]); pw[kt][sp].y = cvtpk(S[kt][8 * sp + 2], S[kt][8 * sp + 3]); pw[kt][sp].z = cvtpk(S[kt][8 * sp + 4], S[kt][8 * sp + 5]); pw[kt][sp].w = cvtpk(S[kt][8 * sp + 6], S[kt][8 * sp + 7]); } }
    l += __shfl_xor(l, 32);
#pragma unroll
    for (int e = 0; e < 16; ++e) { O0[e] = 0.f; O1[e] = 0.f; }
    attn_pv_tile(vst, lane, trb, va, pw[0], O0, O1);          attn_load_v(T, 2, lane, va);
    attn_pv_tile(vst + 4096, lane, trb, vb4, pw[1], O0, O1);  attn_load_v(T, 3, lane, vb4);
    attn_pv_tile(vst, lane, trb, va, pw[2], O0, O1);          attn_load_v(T, 4, lane, va);
    attn_pv_tile(vst + 4096, lane, trb, vb4, pw[3], O0, O1);
    attn_pv_tile(vst, lane, trb, va, pw[4], O0, O1);
}
constexpr int AF_ROWB = 136, AF_LSE = 512 * AF_ROWB, AF_VST = AF_LSE + 2048;
__device__ __forceinline__ void attn_fused(Frame& F, const bf16* QKV, bf16* Y) {
    LOCAL_IDS;
    const int jq = lane & 31, hh = lane >> 5;
    LAS unsigned char* tab = F.lds + RING_OFF; LAS float* lseL = (LAS float*)(F.lds + RING_OFF + AF_LSE);
    LAS unsigned char* vst = F.lds + RING_OFF + AF_VST + wave * 8192;
    const int trb = ((lane >> 4) & 1) * 32 + (lane & 3) * 8 + (4 * hh + ((lane & 15) >> 2)) * 64;
    for (int u = F.vcu; u < 256; u += F.G) {
        const int blk = u & 7, h = (u >> 3) & 7, b = u >> 6;
#pragma unroll
        for (int g = 0; g < 3; ++g) {
            const int sh = 2 * g;
            for (int qi = 0; qi < 2; ++qi) {
                const int q16 = 2 * wave + qi;
                AttnTask T; T.g = g; T.b = b; T.sh = sh;
                T.r = g == 0 ? 0 : (g == 1 ? (q16 >> 2) : q16);
                T.m0 = g == 0 ? 512 * blk + 32 * q16 : (g == 1 ? 128 * blk + 32 * (q16 & 3) : 32 * blk);
                T.base = QKV + ((size_t)((b * 3 + g) * 8 + h) * 4096 + (size_t)T.r * (4096 >> sh)) * 64;
                T.kt_lo = T.m0 >= 128 ? 0 : 4 - (T.m0 >> 5);
                f32x16 O0, O1; float l, mx;
                attn_core(T, jq, hh, lane, vst, trb, O0, O1, l, mx);
                const float inv = 1.0f / l; float lse = mx * 0.125f + __logf(l);
                const int pos = ((T.m0 + jq) << sh) + T.r - 512 * blk;
                LAS unsigned char* trow = tab + pos * AF_ROWB + 8 * hh;
                float wa = 0.f, wb = 1.0f;
                if (g > 0) { const float la = lseL[pos], M = fmaxf(la, lse); const float ea = __expf(la - M), eb = __expf(lse - M), rs = 1.0f / (ea + eb); wa = ea * rs; wb = eb * rs; lse = M + __logf(ea + eb); }
                wb *= inv;
#pragma unroll
                for (int a4 = 0; a4 < 4; ++a4) {
                    float o0[4], o1[4];
#pragma unroll
                    for (int e = 0; e < 4; ++e) { o0[e] = O0[4 * a4 + e] * wb; o1[e] = O1[4 * a4 + e] * wb; }
                    if (g > 0) { const u32x2 p0 = *(const LAS u32x2*)(trow + 16 * a4), p1 = *(const LAS u32x2*)(trow + 64 + 16 * a4);
                        o0[0] += wa * bflo(p0.x); o0[1] += wa * bfhi(p0.x); o0[2] += wa * bflo(p0.y); o0[3] += wa * bfhi(p0.y);
                        o1[0] += wa * bflo(p1.x); o1[1] += wa * bfhi(p1.x); o1[2] += wa * bflo(p1.y); o1[3] += wa * bfhi(p1.y); }
                    u32x2 w0; w0.x = cvtpk(o0[0], o0[1]); w0.y = cvtpk(o0[2], o0[3]); *(LAS u32x2*)(trow + 16 * a4) = w0;
                    u32x2 w1; w1.x = cvtpk(o1[0], o1[1]); w1.y = cvtpk(o1[2], o1[3]); *(LAS u32x2*)(trow + 64 + 16 * a4) = w1; }
                if (hh == 0) lseL[pos] = lse;
            }
            __syncthreads();
        }
#pragma unroll
        for (int k = 0; k < 8; ++k) { const int pc = tid + NTHREADS * k, pos = pc >> 3, c8 = pc & 7;
            const u32x2 x0 = *(const LAS u32x2*)(tab + pos * AF_ROWB + c8 * 16), x1 = *(const LAS u32x2*)(tab + pos * AF_ROWB + c8 * 16 + 8);
            *(GAS v4u*)(Y + ((size_t)(b * SEQ + 512 * blk + pos)) * AW + h * 64 + c8 * 8) = (v4u){x0.x, x0.y, x1.x, x1.y}; }
        __syncthreads();
    }
}

__device__ __forceinline__ void attn_prompt_shared(Frame& F, const bf16* QKV, bf16* OG, float* LSE) {
    LOCAL_IDS;
    const int jq = lane & 31, hh = lane >> 5;
    LAS unsigned char* kimg = F.lds + RING_OFF;
    LAS unsigned char* vimg = F.lds + RING_OFF + 49152;
    const int trb = ((lane >> 4) & 1) * 32 + (lane & 3) * 8 + (4 * hh + ((lane & 15) >> 2)) * 64;
    constexpr size_t SECSTR = (size_t)4 * 3 * 8 * 4096 * 64;
    const float NEG = -INFINITY, c = 0.125f * 1.4426950408889634f;
    int u = F.vcu;
    if (u >= 1536) return;
    v4u kx[6], vx[6]; bf16x8 qf[4];
#define AS_DECODE(U, BASE, M0, SH, R, B_, G_, H_) \
    const int uq_ = (U) & 15, bgh_ = (U) >> 4; const int H_ = bgh_ & 7, G_ = (bgh_ >> 3) % 3, B_ = (bgh_ >> 3) / 3, SH = 2 * G_; \
    const int R = uq_ >> (4 - SH), M0 = 256 * (uq_ & ((16 >> SH) - 1)); \
    const bf16* BASE = QKV + ((size_t)((B_ * 3 + G_) * 8 + H_) * 4096 + (size_t)R * (4096 >> SH)) * 64;
#define AS_LOAD(BASE, M0) { _Pragma("unroll") for (int n = 0; n < 6; ++n) { const int idx = wave + 8 * n; \
        { const int tile = idx >> 2, chunk = 2 * (idx & 3) + (lane >> 5); int kpos = (M0) - 128 + tile * 32 + (lane & 31); kpos = kpos < 0 ? 0 : kpos; \
          kx[n] = *(const GAS v4u*)((BASE) + SECSTR + (size_t)kpos * 64 + chunk * 8); } \
        { const int tile = idx >> 2, dh = (idx >> 1) & 1, key = (lane >> 2) + 16 * (idx & 1); int kpos = (M0) - 128 + tile * 32 + key; kpos = kpos < 0 ? 0 : kpos; \
          vx[n] = *(const GAS v4u*)((BASE) + 2 * SECSTR + (size_t)kpos * 64 + dh * 32 + (lane & 3) * 8); } } \
        { const bf16* qp_ = (BASE) + (size_t)((M0) + 32 * wave + jq) * 64 + 32 * hh; _Pragma("unroll") for (int s = 0; s < 4; ++s) qn[s] = *(const GAS bf16x8*)(qp_ + 8 * s); } }
    bf16x8 qn[4];
    { AS_DECODE(u, base0, m00, sh0, r0, b0, g0, h0) (void)sh0; (void)r0; (void)b0; (void)g0; (void)h0; AS_LOAD(base0, m00) }
    for (;;) {
        AS_DECODE(u, base, m0, sh, r, b, g, h)
        __syncthreads();
#pragma unroll
        for (int n = 0; n < 6; ++n) { const int idx = wave + 8 * n;
            *(LAS v4u*)(kimg + (idx >> 2) * 4096 + (2 * (idx & 3) + (lane >> 5)) * 512 + (lane & 31) * 16) = kx[n];
            *(LAS v4u*)(vimg + (idx >> 2) * 4096 + ((idx >> 1) & 1) * 2048 + ((lane >> 2) + 16 * (idx & 1)) * 64 + (lane & 3) * 16) = vx[n]; }
        __syncthreads();
#pragma unroll
        for (int s = 0; s < 4; ++s) qf[s] = qn[s];
        const int un = u + F.G; const bool more = un < 1536;
        if (more) { AS_DECODE(un, basen, m0n, shn, rn, bn, gn, hn) (void)shn; (void)rn; (void)bn; (void)gn; (void)hn; AS_LOAD(basen, m0n) }
        const int mq = m0 + 32 * wave; const int kt_lo = mq >= 128 ? 0 : 4 - (mq >> 5);
        f32x16 S[5];
#pragma unroll
        for (int kt = 0; kt < 5; ++kt) {
            const float z0 = (kt < 4 && kt < kt_lo) ? NEG : 0.f;
#pragma unroll
            for (int e = 0; e < 16; ++e) S[kt][e] = z0;
            const LAS unsigned char* kb = kimg + (wave + kt) * 4096 + (4 * hh) * 512 + jq * 16;
#pragma unroll
            for (int s = 0; s < 4; ++s) { const bf16x8 kf = *(const LAS bf16x8*)(kb + s * 512); S[kt] = __builtin_amdgcn_mfma_f32_32x32x16_bf16(kf, qf[s], S[kt], 0, 0, 0); }
        }
#pragma unroll
        for (int e = 0; e < 16; ++e) { const int i = (e & 3) + 8 * (e >> 2) + 4 * hh; if (i < jq) S[0][e] = NEG; if (i > jq) S[4][e] = NEG; }
        float mx = NEG;
#pragma unroll
        for (int kt = 0; kt < 5; ++kt)
#pragma unroll
            for (int e = 0; e < 16; ++e) mx = fmaxf(mx, S[kt][e]);
        mx = fmaxf(mx, __shfl_xor(mx, 32));
        float l = 0.f; u32x4 pw[5][2]; const float nmc = -mx * c;
#pragma unroll
        for (int kt = 0; kt < 5; ++kt) {
#pragma unroll
            for (int e = 0; e < 16; ++e) { const float pv = __builtin_amdgcn_exp2f(__builtin_fmaf(S[kt][e], c, nmc)); S[kt][e] = pv; l += pv; }
#pragma unroll
            for (int sp = 0; sp < 2; ++sp) { pw[kt][sp].x = cvtpk(S[kt][8 * sp + 0], S[kt][8 * sp + 1]); pw[kt][sp].y = cvtpk(S[kt][8 * sp + 2], S[kt][8 * sp + 3]); pw[kt][sp].z = cvtpk(S[kt][8 * sp + 4], S[kt][8 * sp + 5]); pw[kt][sp].w = cvtpk(S[kt][8 * sp + 6], S[kt][8 * sp + 7]); } }
        l += __shfl_xor(l, 32);
        f32x16 O0, O1;
#pragma unroll
        for (int e = 0; e < 16; ++e) { O0[e] = 0.f; O1[e] = 0.f; }
#pragma unroll
        for (int kt = 0; kt < 5; ++kt) { const LAS unsigned char* vb = vimg + (wave + kt) * 4096;
#pragma unroll
            for (int sp = 0; sp < 2; ++sp) { const bf16x8 pf = __builtin_bit_cast(bf16x8, pw[kt][sp]);
                { const s16x4 lo = vtr(vb + sp * 1024 + trb), hi = vtr(vb + sp * 1024 + 512 + trb);
                  const bf16x8 vf = (bf16x8){lo[0], lo[1], lo[2], lo[3], hi[0], hi[1], hi[2], hi[3]};
                  O0 = __builtin_amdgcn_mfma_f32_32x32x16_bf16(vf, pf, O0, 0, 0, 0); }
                { const s16x4 lo = vtr(vb + 2048 + sp * 1024 + trb), hi = vtr(vb + 2048 + sp * 1024 + 512 + trb);
                  const bf16x8 vf = (bf16x8){lo[0], lo[1], lo[2], lo[3], hi[0], hi[1], hi[2], hi[3]};
                  O1 = __builtin_amdgcn_mfma_f32_32x32x16_bf16(vf, pf, O1, 0, 0, 0); } } }
        const float inv = 1.0f / l;
        const int row = b * SEQ + ((mq + jq) << sh) + r;
        { LAS unsigned char* stg = F.lds + RING_OFF + 98304 + wave * 4352;
          LAS unsigned char* srow = stg + jq * 136 + 8 * hh;
#pragma unroll
          for (int a4 = 0; a4 < 4; ++a4) {
              u32x2 w0; w0.x = cvtpk(O0[4 * a4] * inv, O0[4 * a4 + 1] * inv); w0.y = cvtpk(O0[4 * a4 + 2] * inv, O0[4 * a4 + 3] * inv); *(LAS u32x2*)(srow + 16 * a4) = w0;
              u32x2 w1; w1.x = cvtpk(O1[4 * a4] * inv, O1[4 * a4 + 1] * inv); w1.y = cvtpk(O1[4 * a4 + 2] * inv, O1[4 * a4 + 3] * inv); *(LAS u32x2*)(srow + 64 + 16 * a4) = w1; }
          bf16* ob = OG + ((size_t)((g * 4 + b) * 8 + h) * 4096 + (size_t)r * (4096 >> sh) + mq) * 64;
#pragma unroll
          for (int it = 0; it < 4; ++it) { const int q = it * 8 + (lane >> 3), pc = lane & 7;
              const u32x2 x0 = *(const LAS u32x2*)(stg + q * 136 + pc * 16), x1 = *(const LAS u32x2*)(stg + q * 136 + pc * 16 + 8);
              *(GAS v4u*)(ob + q * 64 + pc * 8) = (v4u){x0.x, x0.y, x1.x, x1.y}; } }
        if (hh == 0) LSE[((size_t)row * 8 + h) * 4 + g] = mx * 0.125f + __logf(l);
        if (!more) break;
        u = un;
    }
#undef AS_DECODE
#undef AS_LOAD
}
__device__ __forceinline__ f32x4 ld_new4(const bf16* p) { const u32x2 w = *(const GAS u32x2*)p; return (f32x4){bflo(w.x), bfhi(w.x), bflo(w.y), bfhi(w.y)}; }
__device__ __forceinline__ float row16_sum(float v) {
    v += __builtin_bit_cast(float, __builtin_amdgcn_update_dpp(0, __builtin_bit_cast(int, v), 0xB1, 0xF, 0xF, false));
    v += __builtin_bit_cast(float, __builtin_amdgcn_update_dpp(0, __builtin_bit_cast(int, v), 0x4E, 0xF, 0xF, false));
    v += __builtin_bit_cast(float, __builtin_amdgcn_update_dpp(0, __builtin_bit_cast(int, v), 0x141, 0xF, 0xF, false));
    v += __builtin_bit_cast(float, __builtin_amdgcn_update_dpp(0, __builtin_bit_cast(int, v), 0x140, 0xF, 0xF, false));
    return v;
}
__device__ __forceinline__ void attn_sample_v2(Frame& F, const Args& a, const bf16* QKV, bf16* OG, float* LSE, int li) {
    LOCAL_IDS;
    const int kk = lane >> 4, dp = lane & 15;
    const int gw = F.vcu * NWAVES + wave, NGW = F.G * NWAVES;
    for (int task = gw; task < MS * 24; task += NGW) {
        const int h = task & 7, g = (task >> 3) % 3, sr = task / 24, sb = sr >> 2, t = sr & 3, r = MP + sr;
        const int sh = 2 * g, dil = 1 << sh, L = 128 << sh;
        const float* cache = kin(2 + g) + ((size_t)(li * SB + sb) * L) * 1024 + h * 64 + 4 * dp;
        const float* newkv = kout() + (g == 0 ? O_KV128S : (g == 1 ? O_KV512S : O_KV2048S)) + ((size_t)(li * SB + sb) * 4) * 1024 + h * 64 + 4 * dp;
        const f32x4 q4 = ld_new4(QKV + (size_t)r * QW + g * 512 + h * 64 + 4 * dp);
        float sa[11], sb_[11], sc_[11];
#define SK_BATCH(BT, SARR) { f32x4 kv[11]; \
            _Pragma("unroll") for (int i = 0; i < 11; ++i) { const int it = 11 * (BT) + i, j0 = 4 * it + kk, j = j0 > 128 ? 128 : j0, idx = L + t - dil * j; \
                const float* rp = idx >= L ? newkv + (size_t)(idx - L) * 1024 : cache + (size_t)idx * 1024; kv[i] = *(const GAS f32x4*)rp; } \
            _Pragma("unroll") for (int i = 0; i < 11; ++i) { const int it = 11 * (BT) + i, j0 = 4 * it + kk; \
                const float s = row16_sum((q4.x * kv[i].x + q4.y * kv[i].y) + (q4.z * kv[i].z + q4.w * kv[i].w)); \
                SARR[i] = j0 <= 128 ? 0.125f * s : -INFINITY; } }
        SK_BATCH(0, sa) SK_BATCH(1, sb_) SK_BATCH(2, sc_)
#undef SK_BATCH
        float mx = sa[0];
#pragma unroll
        for (int i = 0; i < 11; ++i) mx = fmaxf(fmaxf(mx, sa[i]), fmaxf(sb_[i], sc_[i]));
        mx = fmaxf(mx, __shfl_xor(mx, 16)); mx = fmaxf(mx, __shfl_xor(mx, 32));
        float l = 0.f;
#pragma unroll
        for (int i = 0; i < 11; ++i) { sa[i] = __expf(sa[i] - mx); sb_[i] = __expf(sb_[i] - mx); sc_[i] = __expf(sc_[i] - mx); l += (sa[i] + sb_[i]) + sc_[i]; }
        l += __shfl_xor(l, 16); l += __shfl_xor(l, 32);
        f32x4 o = (f32x4){0.f, 0.f, 0.f, 0.f};
#define SV_BATCH(BT, SARR) { f32x4 vv[11]; \
            _Pragma("unroll") for (int i = 0; i < 11; ++i) { const int it = 11 * (BT) + i, j0 = 4 * it + kk, j = j0 > 128 ? 128 : j0, idx = L + t - dil * j; \
                const float* rp = idx >= L ? newkv + (size_t)(idx - L) * 1024 : cache + (size_t)idx * 1024; vv[i] = *(const GAS f32x4*)(rp + 512); } \
            _Pragma("unroll") for (int i = 0; i < 11; ++i) o = o + vv[i] * SARR[i]; }
        SV_BATCH(0, sa) SV_BATCH(1, sb_) SV_BATCH(2, sc_)
#undef SV_BATCH
#pragma unroll
        for (int e = 0; e < 4; ++e) { o[e] += __shfl_xor(o[e], 16); o[e] += __shfl_xor(o[e], 32); }
        const float inv = 1.0f / l;
        if (kk == 0) { u32x2 w; w.x = cvtpk(o[0] * inv, o[1] * inv); w.y = cvtpk(o[2] * inv, o[3] * inv); *(GAS u32x2*)(OG + ((size_t)g * MS + sr) * AW + h * 64 + 4 * dp) = w; }
        if (lane == 0) LSE[((size_t)r * 8 + h) * 4 + g] = mx + __logf(l);
    }
}

__device__ __forceinline__ void attn_sample_v3(Frame& F, const Args& a, const bf16* QKV, bf16* Y, int li) {
    LOCAL_IDS;
    const int kk = lane >> 4, dp = lane & 15;
    const int gw = F.vcu * NWAVES + wave, NGW = F.G * NWAVES;
    for (int task = gw; task < MS * 8; task += NGW) {
        const int h = task & 7, sr = task >> 3, sb = sr >> 2, t = sr & 3, r = MP + sr;
        f32x4 og[3]; float lg[3];
#pragma unroll
        for (int g = 0; g < 3; ++g) {
        const int sh = 2 * g, dil = 1 << sh, L = 128 << sh;
        const float* cache = kin(2 + g) + ((size_t)(li * SB + sb) * L) * 1024 + h * 64 + 4 * dp;
        const bf16* qn = QKV + (size_t)(MP + sb * 4) * QW + g * 512 + h * 64 + 4 * dp;
        const f32x4 q4 = ld_new4(QKV + (size_t)r * QW + g * 512 + h * 64 + 4 * dp);
        float sc[33];
#pragma unroll
        for (int it = 0; it < 33; ++it) { const int j = 4 * it + kk, idx = L + t - dil * j; float s = 0.f;
            if (j <= 128) { const f32x4 kv = idx >= L ? ld_new4(qn + (size_t)(idx - L) * QW + 1536) : *(const GAS f32x4*)(cache + (size_t)idx * 1024);
                s = (q4.x * kv.x + q4.y * kv.y) + (q4.z * kv.z + q4.w * kv.w); }
            s += __shfl_xor(s, 1); s += __shfl_xor(s, 2); s += __shfl_xor(s, 4); s += __shfl_xor(s, 8);
            sc[it] = j <= 128 ? 0.125f * s : -INFINITY;
            if ((it & 7) == 7) asm volatile("" ::: "memory"); }
        float mx = sc[0];
#pragma unroll
        for (int it = 1; it < 33; ++it) mx = fmaxf(mx, sc[it]);
        mx = fmaxf(mx, __shfl_xor(mx, 16)); mx = fmaxf(mx, __shfl_xor(mx, 32));
        float l = 0.f;
#pragma unroll
        for (int it = 0; it < 33; ++it) { sc[it] = __expf(sc[it] - mx); l += sc[it]; }
        l += __shfl_xor(l, 16); l += __shfl_xor(l, 32);
        f32x4 o = (f32x4){0.f, 0.f, 0.f, 0.f};
#pragma unroll
        for (int it = 0; it < 33; ++it) { const int j = 4 * it + kk, idx = L + t - dil * j;
            if (j <= 128) { const f32x4 vv = idx >= L ? ld_new4(qn + (size_t)(idx - L) * QW + 3072) : *(const GAS f32x4*)(cache + (size_t)idx * 1024 + 512);
                o = o + vv * sc[it]; }
            if ((it & 7) == 7) asm volatile("" ::: "memory"); }
#pragma unroll
        for (int e = 0; e < 4; ++e) { o[e] += __shfl_xor(o[e], 16); o[e] += __shfl_xor(o[e], 32); }
        og[g] = o * (1.0f / l); lg[g] = mx + __logf(l);
        }
        const float M = fmaxf(fmaxf(lg[0], lg[1]), lg[2]); const float w0 = __expf(lg[0] - M), w1 = __expf(lg[1] - M), w2 = __expf(lg[2] - M), rs = 1.0f / (w0 + w1 + w2);
        const f32x4 y = (og[0] * w0 + og[1] * w1 + og[2] * w2) * rs;
        if (kk == 0) { u32x2 w; w.x = cvtpk(y[0], y[1]); w.y = cvtpk(y[2], y[3]); *(GAS u32x2*)(Y + (size_t)r * AW + h * 64 + 4 * dp) = w; }
    }
}
__device__ __forceinline__ void spatial_prompt_mfma(Frame& F, const Args& a, const bf16* UV, bf16* Z, const bf16* Wsb, const float* VS, int li) {
    LOCAL_IDS;
    LAS unsigned char* img = F.lds + RING_OFF;
    LAS float* st = (LAS float*)(F.lds + RING_OFF + 126976);
    const int tt = wave & 3, chalf = wave >> 2;
    const float* lng = kin(15) + li * DV; const float* lnb = kin(16) + li * DV;
    for (int u = F.vcu; u < 256; u += F.G) {
        const int cidx = u >> 1, ghalf = u & 1, row0 = cidx * 128;
        int td_ = tid; asm volatile("" : "+v"(td_)); const int c8b = td_ % 48, sr = td_ / 48, cb = c8b * 8;
        const bool builder = td_ < 480;
        v4u x[13]; f32x4 g0, g1, b0, b1;
        { const int ch0 = (ghalf * 4) * 384; const bf16* vp = UV + (size_t)(row0 + sr) * UVW + DV + ch0 + cb;
          if (builder) { g0 = *(const GAS f32x4*)(lng + ch0 + cb); g1 = *(const GAS f32x4*)(lng + ch0 + cb + 4); b0 = *(const GAS f32x4*)(lnb + ch0 + cb); b1 = *(const GAS f32x4*)(lnb + ch0 + cb + 4);
#pragma unroll
              for (int k = 0; k < 13; ++k) x[k] = (sr + 10 * k) < 128 ? *(const GAS v4u*)(vp + (size_t)(10 * k) * UVW) : (v4u){0u, 0u, 0u, 0u}; } }
        __syncthreads();
        { typedef float f32x2 __attribute__((ext_vector_type(2)));
          int t4_ = tid; asm volatile("" : "+v"(t4_)); const int rr = t4_ >> 2, qd = t4_ & 3; const f32x2* vp = (const f32x2*)(VS + ((size_t)(row0 + rr) * 48 + qd * 12) * 2); float s1 = 0.f, s2 = 0.f;
#pragma unroll
          for (int j = 0; j < 12; ++j) { const f32x2 xx = vp[j]; s1 += xx.x; s2 += xx.y; }
          s1 += __shfl_xor(s1, 1); s1 += __shfl_xor(s1, 2); s2 += __shfl_xor(s2, 1); s2 += __shfl_xor(s2, 2);
          const float mean = s1 * (1.0f / DV), var = s2 * (1.0f / DV) - mean * mean;
          if (qd == 0) { st[2 * rr] = mean; st[2 * rr + 1] = __builtin_amdgcn_rsqf(fmaxf(var, 0.f) + LN_EPS); } }
        __syncthreads();
        for (int gi = 0; gi < 4; ++gi) {
            const int gg = ghalf * 4 + gi, ch0 = gg * 384;
            int l5_ = lane; asm volatile("" : "+v"(l5_)); const int tl = l5_ & 31, hh = l5_ >> 5, trbn = ((l5_ >> 4) & 1) * 32 + (l5_ & 3) * 8 + (8 * hh + ((l5_ & 15) >> 2)) * 64;
            const bf16* wp = Wsb + ((size_t)((li * 8 + gg) * 128 + 32 * tt + tl)) * 128 + 8 * hh;
            const float bt = kin(18)[(li * 8 + gg) * 128 + 32 * tt + tl];
            bf16x8 wfr[8];
#pragma unroll
            for (int ks = 0; ks < 8; ++ks) wfr[ks] = *(const GAS bf16x8*)(wp + 16 * ks);
            if (builder) {
#pragma unroll
                for (int k = 0; k < 13; ++k) { const int s = sr + 10 * k;
                    if (s < 128) { const float mean = st[2 * s], rstd = st[2 * s + 1]; v4u o;
                        o.x = pk2((bflo(x[k].x) - mean) * rstd * g0.x + b0.x, (bfhi(x[k].x) - mean) * rstd * g0.y + b0.y); o.y = pk2((bflo(x[k].y) - mean) * rstd * g0.z + b0.z, (bfhi(x[k].y) - mean) * rstd * g0.w + b0.w);
                        o.z = pk2((bflo(x[k].z) - mean) * rstd * g1.x + b1.x, (bfhi(x[k].z) - mean) * rstd * g1.y + b1.y); o.w = pk2((bflo(x[k].w) - mean) * rstd * g1.z + b1.z, (bfhi(x[k].w) - mean) * rstd * g1.w + b1.w);
                        *(LAS v4u*)(img + (cb >> 5) * 8192 + s * 64 + (cb & 31) * 2) = o; } }
            }
            __syncthreads();
            f32x16 acc[6];
#pragma unroll
            for (int ct = 0; ct < 6; ++ct)
#pragma unroll
                for (int e = 0; e < 16; ++e) acc[ct][e] = 0.f;
#pragma unroll
            for (int ks = 0; ks < 8; ++ks) if (ks < 2 * (tt + 1)) {
                const bf16x8 wf = wfr[ks];
#pragma unroll
                for (int ct = 0; ct < 6; ++ct) { const LAS unsigned char* ib = img + (chalf * 6 + ct) * 8192 + ks * 1024 + trbn;
                    const s16x4 lo = vtr(ib), hi = vtr(ib + 256);
                    const bf16x8 vf = (bf16x8){lo[0], lo[1], lo[2], lo[3], hi[0], hi[1], hi[2], hi[3]};
                    acc[ct] = __builtin_amdgcn_mfma_f32_32x32x16_bf16(vf, wf, acc[ct], 0, 0, 0); }
            }
            int ln_ = lane; asm volatile("" : "+v"(ln_));
            v4u uu[12];
#pragma unroll
            for (int k = 0; k < 12; ++k) { const int pc = ln_ + 64 * k, tr = pc / 24, c8 = pc - tr * 24;
                uu[k] = *(const GAS v4u*)(UV + (size_t)(row0 + 32 * tt + tr) * UVW + ch0 + chalf * 192 + c8 * 8); }
            __syncthreads();
            LAS unsigned char* stg = img + wave * 12800;
            {
#pragma unroll
              for (int ct = 0; ct < 6; ++ct)
#pragma unroll
                  for (int a4 = 0; a4 < 4; ++a4) { u32x2 mm; mm.x = cvtpk(acc[ct][4 * a4] + bt, acc[ct][4 * a4 + 1] + bt); mm.y = cvtpk(acc[ct][4 * a4 + 2] + bt, acc[ct][4 * a4 + 3] + bt);
                      *(LAS u32x2*)(stg + tl * 400 + (32 * ct + 8 * a4 + 4 * hh) * 2) = mm; } }
            asm volatile("" ::: "memory");
            if (gi < 3 && builder) {
                int t2_ = tid; asm volatile("" : "+v"(t2_)); const int cb2 = (t2_ % 48) * 8, sr2 = t2_ / 48;
                const int ch1 = ch0 + 384; const bf16* vp = UV + (size_t)(row0 + sr2) * UVW + DV + ch1 + cb2;
                g0 = *(const GAS f32x4*)(lng + ch1 + cb2); g1 = *(const GAS f32x4*)(lng + ch1 + cb2 + 4); b0 = *(const GAS f32x4*)(lnb + ch1 + cb2); b1 = *(const GAS f32x4*)(lnb + ch1 + cb2 + 4);
#pragma unroll
                for (int k = 0; k < 13; ++k) x[k] = (sr2 + 10 * k) < 128 ? *(const GAS v4u*)(vp + (size_t)(10 * k) * UVW) : (v4u){0u, 0u, 0u, 0u}; }
            int l3_ = lane; asm volatile("" : "+v"(l3_));
#pragma unroll
            for (int k = 0; k < 12; ++k) { const int pc = l3_ + 64 * k, tr = pc / 24, c8 = pc - tr * 24;
                const v4u mm = *(const LAS v4u*)(stg + tr * 400 + c8 * 16);
                v4u zz; zz.x = cvtpk(bflo(uu[k].x) * bflo(mm.x), bfhi(uu[k].x) * bfhi(mm.x)); zz.y = cvtpk(bflo(uu[k].y) * bflo(mm.y), bfhi(uu[k].y) * bfhi(mm.y));
                zz.z = cvtpk(bflo(uu[k].z) * bflo(mm.z), bfhi(uu[k].z) * bfhi(mm.z)); zz.w = cvtpk(bflo(uu[k].w) * bflo(mm.w), bfhi(uu[k].w) * bfhi(mm.w));
                *(GAS v4u*)(Z + (size_t)(row0 + 32 * tt + tr) * DV + ch0 + chalf * 192 + c8 * 8) = zz; }
            __syncthreads();
        }
    }
}
template <int MODE>
__device__ __forceinline__ void sample_gemm(Frame& F, const bf16* A, const bf16* Bt, int N, int K, float* X, bf16* XB, float* SS, float scale, bf16* UVo) {
    LOCAL_IDS;
    LAS float* part = (LAS float*)(F.lds + RING_OFF);
    const int fr = lane & 15, kq = lane >> 4;
    const int ntile = 8 * (N >> 6), ksl = K >> 3, nst = ksl >> 5;
    for (int tile = F.vcu; tile < ntile; tile += F.G) {
        const int rf = tile & 7, ct = tile >> 3;
        float rs_pre = 0.f; if (MODE == 1) rs_pre = pg8::row_rstd32(SS, 16 * rf + (tid >> 5));
        const bf16* ap = A + (size_t)(16 * rf + fr) * K + wave * ksl + 8 * kq;
        const bf16* bp = Bt + (size_t)(64 * ct + fr) * K + wave * ksl + 8 * kq;
        f32x4 acc[4];
#pragma unroll
        for (int cf = 0; cf < 4; ++cf) acc[cf] = (f32x4){0.f, 0.f, 0.f, 0.f};
        for (int s0 = 0; s0 < nst; s0 += 4) {
            bf16x8 af[4], bfr[4][4];
#pragma unroll
            for (int s = 0; s < 4; ++s) if (s0 + s < nst) { af[s] = *(const GAS bf16x8*)(ap + 32 * (s0 + s));
#pragma unroll
                for (int cf = 0; cf < 4; ++cf) bfr[s][cf] = *(const GAS bf16x8*)(bp + (size_t)cf * 16 * K + 32 * (s0 + s)); }
            asm volatile("" ::: "memory");
#pragma unroll
            for (int s = 0; s < 4; ++s) if (s0 + s < nst) asm volatile("" : "+v"(af[s]), "+v"(bfr[s][0]), "+v"(bfr[s][1]), "+v"(bfr[s][2]), "+v"(bfr[s][3]));
#pragma unroll
            for (int s = 0; s < 4; ++s) if (s0 + s < nst) {
#pragma unroll
                for (int cf = 0; cf < 4; ++cf) acc[cf] = __builtin_amdgcn_mfma_f32_16x16x32_bf16(af[s], bfr[s][cf], acc[cf], 0, 0, 0); }
        }
#pragma unroll
        for (int cf = 0; cf < 4; ++cf)
#pragma unroll
            for (int e = 0; e < 4; ++e) part[(wave * 16 + 4 * kq + e) * 68 + 16 * cf + fr] = acc[cf][e];
        __syncthreads();
        { const int r = tid >> 5, c = 2 * (tid & 31); float s0 = 0.f, s1 = 0.f;
#pragma unroll
          for (int w = 0; w < 8; ++w) { s0 += part[(w * 16 + r) * 68 + c]; s1 += part[(w * 16 + r) * 68 + c + 1]; }
          const int grow = MP + 16 * rf + r, gcol = 64 * ct + c;
          if (MODE == 0) {
              const unsigned xo = *(const GAS unsigned*)(XB + (size_t)grow * DM + gcol);
              const unsigned w = cvtpk(bflo(xo) + scale * s0, bfhi(xo) + scale * s1);
              *(GAS unsigned*)(XB + (size_t)grow * DM + gcol) = w;
              float ss = bflo(w) * bflo(w) + bfhi(w) * bfhi(w);
              ss += __shfl_xor(ss, 1); ss += __shfl_xor(ss, 2); ss += __shfl_xor(ss, 4); ss += __shfl_xor(ss, 8); ss += __shfl_xor(ss, 16);
              if ((tid & 31) == 0) SS[(size_t)grow * 16 + ct] = ss;
          } else {
              const float rs = rs_pre;
              *(GAS unsigned*)(UVo + (size_t)grow * UVW + gcol) = cvtpk(pg8::gelu_tanh_f(s0 * rs), pg8::gelu_tanh_f(s1 * rs));
          } }
        __syncthreads();
    }
}

template <int NST>
__device__ __forceinline__ void sample_resid(Frame& F, const bf16* A, const bf16* Bt, float* SSS, bf16* XB, float scale, const XcdBarrier* seam = nullptr) {
    LOCAL_IDS;
    constexpr int K = NST * 256;
    LAS float* part = (LAS float*)(F.lds + RING_OFF);
    const int fr = lane & 15, kq = lane >> 4;
    for (int tile = F.vcu; tile < 256; tile += F.G) {
        const int rf = tile & 7, ct = tile >> 3;
        const bf16* ap = A + (size_t)(16 * rf + fr) * K + wave * (NST * 32) + 8 * kq;
        const bf16* bp = Bt + (size_t)(32 * ct + fr) * K + wave * (NST * 32) + 8 * kq;
        bf16x8 af[NST], b0[NST], b1[NST];
        const bool split = seam != nullptr && tile == F.vcu;
        pg8::StaticOrder Sg; Sg.init(MP, DM, F.G, (int)blockIdx.x);
        if (split) { xcd_barrier_head(); pg8::gemm_prefetch_b<true>(F.lds + RING_OFF, Bt, K, Sg, 0); }
        if (!split || wave != 0) {
#pragma unroll
            for (int s = 0; s < NST; ++s) { b0[s] = *(const GAS bf16x8*)(bp + 32 * s); b1[s] = *(const GAS bf16x8*)(bp + (size_t)16 * K + 32 * s); } }
        if (split) { asm volatile("" ::: "memory"); xcd_barrier_tail(*seam); }
        if (split) pg8::gemm_prefetch_b<true>(F.lds + RING_OFF, Bt, K, Sg, 1);
        if (split && wave == 0) {
#pragma unroll
            for (int s = 0; s < NST; ++s) { b0[s] = *(const GAS bf16x8*)(bp + 32 * s); b1[s] = *(const GAS bf16x8*)(bp + (size_t)16 * K + 32 * s); } }
        const unsigned short xo_pre = XB[(size_t)(MP + 16 * rf + (tid >> 5)) * DM + 32 * ct + (tid & 31)];
#pragma unroll
        for (int s = 0; s < NST; ++s) af[s] = *(const GAS bf16x8*)(ap + 32 * s);
        asm volatile("" ::: "memory");
#pragma unroll
        for (int s = 0; s < NST; ++s) asm volatile("" : "+v"(af[s]), "+v"(b0[s]), "+v"(b1[s]));
        f32x4 acc0 = (f32x4){0.f, 0.f, 0.f, 0.f}, acc1 = (f32x4){0.f, 0.f, 0.f, 0.f};
#pragma unroll
        for (int s = 0; s < NST; ++s) { acc0 = __builtin_amdgcn_mfma_f32_16x16x32_bf16(af[s], b0[s], acc0, 0, 0, 0); acc1 = __builtin_amdgcn_mfma_f32_16x16x32_bf16(af[s], b1[s], acc1, 0, 0, 0); }
#pragma unroll
        for (int e = 0; e < 4; ++e) { part[(wave * 16 + 4 * kq + e) * 36 + fr] = acc0[e]; part[(wave * 16 + 4 * kq + e) * 36 + 16 + fr] = acc1[e]; }
        __syncthreads();
        { const int r = tid >> 5, c = tid & 31; float sum = 0.f;
#pragma unroll
          for (int w = 0; w < 8; ++w) sum += part[(w * 16 + r) * 36 + c];
          const int grow = MP + 16 * rf + r, gcol = 32 * ct + c;
          const unsigned short xo = xo_pre;
          const unsigned short xn = (unsigned short)f2bf(bf2f(xo) + scale * sum);
          XB[(size_t)grow * DM + gcol] = xn;
          float ss = bf2f(xn) * bf2f(xn);
          ss += __shfl_xor(ss, 1); ss += __shfl_xor(ss, 2); ss += __shfl_xor(ss, 4); ss += __shfl_xor(ss, 8); ss += __shfl_xor(ss, 16);
          if (c == 0) SSS[(size_t)(16 * rf + r) * 32 + ct] = ss; }
        __syncthreads();
    }
    if (seam != nullptr && F.vcu >= 256) xcd_barrier(*seam);
}
constexpr int NPH = 34;
#ifndef PROBE_MASK
#define PROBE_MASK 0
#endif
#define REP(bit) (((PROBE_MASK) >> (bit)) & 1 ? 2 : 1)
#ifndef MK_N_LAUNCHES
#define MK_N_LAUNCHES 1
#endif
__global__ void __launch_bounds__(NTHREADS, 2) fwd(Args args) {
    extern __shared__ __attribute__((aligned(16))) unsigned char lds[];
    Frame F;
    F.lds = (LAS unsigned char*)lds;
    F.MISC = (volatile LAS unsigned*)(F.lds + MISC_OFF);
    F.G = gridDim.x; { const int bx = blockIdx.x; F.vcu = (F.G % 8 == 0) ? (bx % 8) * (F.G / 8) + bx / 8 : bx; }
    unsigned char* ws = kws();
    F.ctl = (gu32*)(ws + WS_CTL);
    for (int u = threadIdx.x; u < (LDS_BYTES - LDSCTL_OFF) / 4; u += NTHREADS) ((LAS unsigned*)(F.lds + LDSCTL_OFF))[u] = 0u;
    __syncthreads();
    XcdBarrier bar; bar.bar = (unsigned*)(F.ctl + CW_BAR); bar.x = 0; bar.st = nullptr;
    if (MK_N_LAUNCHES == 1) bar = xcd_barrier_post((unsigned*)(F.ctl + CW_BAR), F.MISC + 8);
#if MK_N_LAUNCHES == 1
    constexpr int lo = 0, hi = NPH;
#else
    const int lo = args.ph_lo, hi = args.ph_hi;
#endif
#define IN(k) (lo <= (k) && (k) < hi)
#define SEAM(k) do { if (IN((k) + 1)) xcd_barrier(bar); } while (0)
    float* X = (float*)(ws + WS_X); bf16* XB = (bf16*)(ws + WS_XB); float* SS = (float*)(ws + WS_SS);
    bool preB = false;
#define PREFETCH_B(k, Bt_, Mr, Nc, Kd) do { if (IN(k)) { __syncthreads();     pg8::StaticOrder Sn; Sn.init((Mr), (Nc), opq(F.G), opq((int)blockIdx.x)); pg8::gemm_prefetch_b<true>(F.lds + RING_OFF, (const bf16*)(Bt_), (Kd), Sn); preB = true; } } while (0)
#define TAKE_PRE(v) const bool v = preB; preB = false
    bf16* BIG = (bf16*)(ws + WS_BIG); bf16* YZ = (bf16*)(ws + WS_YZ);

    if (IN(0)) { for (int rep = 0; rep < REP(0); ++rep) p0_prologue(F, args); SEAM(0); }
    int conv_base = CV_PRO;
    for (int L = 0; L < 4; ++L) {
        const int pb = 1 + 8 * L, li = L >> 1;
        if (IN(pb + 0)) {
            pg8::Gemm g{XB, (const bf16*)(ws + WS_WIN1 + L * SZ_WIN), MROWS, NIN, DM}; pg8::StaticOrder S; S.init(MROWS, NIN, opq(F.G), opq((int)blockIdx.x));
            pg8::fill_rstd_table(F.lds, S, SS, (const float*)(ws + WS_SSS)); pg8::EpiSwiglu E{BIG, (const PG8_LAS float*)(F.lds + pg8::RS_TAB_OFF), DFF};
            TAKE_PRE(pre);
            for (int rep = 0; rep < REP(1); ++rep) pg8::gemm_phase<pg8::EpiSwiglu, pg8::StaticOrder, true, true>(F.lds + RING_OFF, g, S, E, pre && rep == 0);
            conv_base = convert_slack(F, (MROWS / 256) * (NIN / 256), conv_base);
            conv_base = cv_guard(F, conv_base, cv_need(L, 1));
            SEAM(pb + 0);
        }
        if (IN(pb + 1)) {
            for (int rep = 0; rep < REP(10); ++rep) sample_resid<11>(F, BIG + (size_t)MP * DFF, (const bf16*)(ws + WS_WOUT1 + L * SZ_WOUT), (float*)(ws + WS_SSS), XB, (rep == REP(10) - 1 ? 0.5f : 0.0f));
            pg8::Gemm g{BIG, (const bf16*)(ws + WS_WOUT1 + L * SZ_WOUT), MP, DM, DFF}; pg8::StaticOrder S; S.init(MP, DM, opq(F.G), opq((int)blockIdx.x));
            TAKE_PRE(pre);
            for (int rep = 0; rep < REP(2); ++rep) { pg8::EpiResid E{X, XB, SS, rep == REP(2) - 1 ? 0.5f : 0.0f};
            pg8::gemm_phase<pg8::EpiResid, pg8::StaticOrder, true, true>(F.lds + RING_OFF, g, S, E, pre && rep == 0); }
            conv_base = cv_guard(F, conv_base, cv_need(L, 2));
            SEAM(pb + 1);
        }
        if ((L & 1) == 0) {
            if (IN(pb + 2)) {
                pg8::Gemm g{XB, (const bf16*)(ws + WS_WQKV + li * SZ_WQKV), MROWS, QW, DM}; pg8::StaticOrder S; S.init(MROWS, QW, opq(F.G), opq((int)blockIdx.x));
                pg8::fill_rstd_table(F.lds, S, SS, (const float*)(ws + WS_SSS)); pg8::EpiQkv E{BIG, (const PG8_LAS float*)(F.lds + pg8::RS_TAB_OFF), kout(), li};
                TAKE_PRE(pre);
                for (int rep = 0; rep < REP(3); ++rep) pg8::gemm_phase<pg8::EpiQkv, pg8::StaticOrder, true, true>(F.lds + RING_OFF, g, S, E, pre && rep == 0);
                conv_base = convert_slack(F, (MROWS / 256) * (QW / 256), conv_base);
                SEAM(pb + 2);
            }
            if (IN(pb + 3)) { for (int rep = 0; rep < REP(4); ++rep) attn_prompt_shared(F, BIG, (bf16*)(ws + WS_YZ + 20 * MiB), (float*)(ws + WS_YZ + 72 * MiB)); for (int rep = 0; rep < REP(5); ++rep) attn_sample_v2(F, args, BIG, (bf16*)(ws + WS_YZ + 69 * MiB), (float*)(ws + WS_YZ + 72 * MiB), li); SEAM(pb + 3); }
            if (IN(pb + 4)) { for (int rep = 0; rep < REP(6); ++rep) attn_merge(F, (const bf16*)(ws + WS_YZ + 20 * MiB), (const bf16*)(ws + WS_YZ + 69 * MiB), (const float*)(ws + WS_YZ + 72 * MiB), YZ); conv_base = cv_guard(F, conv_base, cv_need(L, 5)); SEAM(pb + 4); }
            if (IN(pb + 5)) {
                for (int rep = 0; rep < REP(10); ++rep) sample_resid<2>(F, YZ + (size_t)MP * AW, (const bf16*)(ws + WS_WOA + li * SZ_WOA), (float*)(ws + WS_SSS), XB, (rep == REP(10) - 1 ? 1.0f : 0.0f));
                pg8::Gemm g{YZ, (const bf16*)(ws + WS_WOA + li * SZ_WOA), MP, DM, AW}; pg8::StaticOrder S; S.init(MP, DM, opq(F.G), opq((int)blockIdx.x));
                TAKE_PRE(pre);
                for (int rep = 0; rep < REP(7); ++rep) { pg8::EpiResid E{X, XB, SS, rep == REP(7) - 1 ? 1.0f : 0.0f};
                pg8::gemm_phase<pg8::EpiResid, pg8::StaticOrder, true, true>(F.lds + RING_OFF, g, S, E, pre && rep == 0); }
                conv_base = cv_guard(F, conv_base, cv_need(L, 6));
                SEAM(pb + 5);
            }
        } else {
            if (IN(pb + 2)) {
                for (int rep = 0; rep < REP(10); ++rep) sample_gemm<1>(F, XB + (size_t)MP * DM, (const bf16*)(ws + WS_WUV + li * SZ_WUV), UVW, DM, nullptr, nullptr, (float*)(ws + WS_SSS), 0.f, BIG);
                pg8::Gemm g{XB, (const bf16*)(ws + WS_WUV + li * SZ_WUV), MP, UVW, DM}; pg8::StaticOrder S; S.init(MP, UVW, opq(F.G), opq((int)blockIdx.x));
                pg8::fill_rstd_table(F.lds, S, SS, (const float*)(ws + WS_SSS)); pg8::EpiUv E{BIG, (const PG8_LAS float*)(F.lds + pg8::RS_TAB_OFF), (float*)(ws + WS_VS)};
                TAKE_PRE(pre);
                for (int rep = 0; rep < REP(8); ++rep) pg8::gemm_phase<pg8::EpiUv, pg8::StaticOrder, true, true>(F.lds + RING_OFF, g, S, E, pre && rep == 0);
                SEAM(pb + 2);
            }
            if (IN(pb + 3)) { for (int rep = 0; rep < REP(9); ++rep) spatial_prompt_mfma(F, args, BIG, YZ, (const bf16*)(ws + WS_WSB), (const float*)(ws + WS_VS), li); for (int rep = 0; rep < REP(11); ++rep) spatial_sample_v1(F, args, BIG, YZ, li); conv_base = cv_guard(F, conv_base, cv_need(L, 5)); if (IN(pb + 5)) xcd_barrier(bar); }
            if (IN(pb + 5)) {
                for (int rep = 0; rep < REP(10); ++rep) sample_resid<12>(F, YZ + (size_t)MP * DV, (const bf16*)(ws + WS_WOB + li * SZ_WOB), (float*)(ws + WS_SSS), XB, (rep == REP(10) - 1 ? 1.0f : 0.0f));
                pg8::Gemm g{YZ, (const bf16*)(ws + WS_WOB + li * SZ_WOB), MP, DM, DV}; pg8::StaticOrder S; S.init(MP, DM, opq(F.G), opq((int)blockIdx.x));
                TAKE_PRE(pre);
                for (int rep = 0; rep < REP(7); ++rep) { pg8::EpiResid E{X, XB, SS, rep == REP(7) - 1 ? 1.0f : 0.0f};
                pg8::gemm_phase<pg8::EpiResid, pg8::StaticOrder, true, true>(F.lds + RING_OFF, g, S, E, pre && rep == 0); }
                conv_base = cv_guard(F, conv_base, cv_need(L, 6));
                SEAM(pb + 5);
            }
        }
        if (IN(pb + 6)) {
            pg8::Gemm g{XB, (const bf16*)(ws + WS_WIN2 + L * SZ_WIN), MROWS, NIN, DM}; pg8::StaticOrder S; S.init(MROWS, NIN, opq(F.G), opq((int)blockIdx.x));
            pg8::fill_rstd_table(F.lds, S, SS, (const float*)(ws + WS_SSS)); pg8::EpiSwiglu E{BIG, (const PG8_LAS float*)(F.lds + pg8::RS_TAB_OFF), DFF};
            TAKE_PRE(pre);
            for (int rep = 0; rep < REP(1); ++rep) pg8::gemm_phase<pg8::EpiSwiglu, pg8::StaticOrder, true, true>(F.lds + RING_OFF, g, S, E, pre && rep == 0);
            conv_base = convert_slack(F, (MROWS / 256) * (NIN / 256), conv_base);
            conv_base = cv_guard(F, conv_base, cv_need(L, 7));
            SEAM(pb + 6);
        }
        if (IN(pb + 7)) {
            for (int rep = 0; rep < REP(10); ++rep) sample_resid<11>(F, BIG + (size_t)MP * DFF, (const bf16*)(ws + WS_WOUT2 + L * SZ_WOUT), (float*)(ws + WS_SSS), XB, (rep == REP(10) - 1 ? 0.5f : 0.0f));
            pg8::Gemm g{BIG, (const bf16*)(ws + WS_WOUT2 + L * SZ_WOUT), MP, DM, DFF}; pg8::StaticOrder S; S.init(MP, DM, opq(F.G), opq((int)blockIdx.x));
            TAKE_PRE(pre);
            for (int rep = 0; rep < REP(2); ++rep) { pg8::EpiResid E{X, XB, SS, rep == REP(2) - 1 ? 0.5f : 0.0f};
            pg8::gemm_phase<pg8::EpiResid, pg8::StaticOrder, true, true>(F.lds + RING_OFF, g, S, E, pre && rep == 0); }
            if (L < 3) conv_base = cv_guard(F, conv_base, cv_need(L + 1, 0));
            SEAM(pb + 7);
        }
    }
    if (IN(33)) final_norm(F, args);
#undef IN
#undef SEAM
}

extern "C" void kernel_launch(void* const* d_in, const int* in_sizes, int n_in, void* d_out, int out_size, void* d_ws, size_t ws_size, hipStream_t stream) {
    static int grid = 0;
    if (grid == 0) {
        if (n_in != 21 || out_size != (int)O_END || ws_size < WS_END) { fprintf(stderr, "kernel_launch: unexpected problem: n_in %d out %d ws %zu (need %zu); nothing launched\n", n_in, out_size, ws_size, (size_t)WS_END); grid = -1; return; }
        int dev = 0, cus = 0, per_cu = 0;
        if (hipGetDevice(&dev) != hipSuccess || hipDeviceGetAttribute(&cus, hipDeviceAttributeMultiprocessorCount, dev) != hipSuccess) { grid = -1; return; }
        if (hipFuncSetAttribute((const void*)fwd, hipFuncAttributeMaxDynamicSharedMemorySize, LDS_BYTES) != hipSuccess) { fprintf(stderr, "kernel_launch: hipFuncSetAttribute failed\n"); grid = -1; return; }
        if (hipOccupancyMaxActiveBlocksPerMultiprocessor(&per_cu, (const void*)fwd, NTHREADS, LDS_BYTES) != hipSuccess || per_cu < 1) { fprintf(stderr, "kernel_launch: occupancy query says %d blocks per CU\n", per_cu); }
        (void)hipGetLastError();
        grid = cus;
    }
    if (grid < 0) return;
    if (hipMemsetAsync((char*)d_ws + WS_CTL, 0, CTL_ZERO_BYTES, stream) != hipSuccess) return;
    Args a{};
    for (int i = 0; i < 21; ++i) a.in[i] = (const float*)d_in[i];
    a.out = (float*)d_out; a.ws = (unsigned char*)d_ws;
    if (MK_N_LAUNCHES == 1) { a.ph_lo = 0; a.ph_hi = NPH; hipLaunchKernelGGL(fwd, dim3(grid), dim3(NTHREADS), LDS_BYTES, stream, a); }
    else for (int p = 0; p < NPH; ++p) { a.ph_lo = p; a.ph_hi = p + 1; hipLaunchKernelGGL(fwd, dim3(grid), dim3(NTHREADS), LDS_BYTES, stream, a); }
}
```

```cpp
#include <hip/hip_runtime.h>
#include <cstdio>
#include <cstdint>
namespace pg8 {
#define PG8_LAS __attribute__((address_space(3)))
typedef unsigned short bf16_t;
typedef short bf16x8 __attribute__((ext_vector_type(8)));
typedef float f32x4 __attribute__((ext_vector_type(4)));
typedef unsigned u32x4 __attribute__((ext_vector_type(4)));
constexpr int BM = 256, BK = 64, HALF = 128, HTB = HALF * BK * 2  , STAGE_BYTES = 8 * HTB, NXCD = 8, WGM = 8;

__host__ __device__ __forceinline__ int lds_byte(int r, int c) { const int ob = (r & 7) * 64 + (c & 31) * 2; return (r >> 3) * 1024 + (c >> 5) * 512 + (ob ^ (((r >> 2) & 1) << 5)); }
__host__ __device__ __forceinline__ void stage_rc(int b, int& R, int& C) { const int sub = b / 1024, sb = b % 1024, kh = sb >> 9, ob = sb & 511, rr = ob >> 6, pre = ob ^ (((rr >> 2) & 1) << 5); R = sub * 8 + rr; C = kh * 32 + (pre & 63) / 2; }
__host__ __device__ __forceinline__ int perm32(int rho) { const int n = rho >> 4, i = rho & 15; return 8 * (i >> 2) + 4 * n + (i & 3); }

struct Unit { int pm, pn, slot; };
struct Gemm { const bf16_t* A; const bf16_t* Bt; int M, N, K; };

struct StaticOrder {
    int nM, nN, nwg, G, c;
    __host__ __device__ void init(int M, int N, int G_, int c_) { nM = M / BM; nN = N / BM; nwg = nM * nN; G = G_; c = c_; }
    __host__ __device__ bool next(int i, Unit& u) const {
        const long L = (long)i * G + c; if (L >= nwg) return false;
        int wgid = (int)L; { const int q = nwg / NXCD, r = nwg % NXCD, xcd = wgid % NXCD, off = wgid / NXCD; wgid = (xcd < r ? xcd * (q + 1) : r * (q + 1) + (xcd - r) * q) + off; }
        const int nig = WGM * nN, gid = wgid / nig, fm = gid * WGM, gsz = (nM - fm) < WGM ? (nM - fm) : WGM;
        u.pm = fm + ((wgid % nig) % gsz); u.pn = (wgid % nig) / gsz; u.slot = i; return true;
    }
    __device__ __forceinline__ void a_ready(const Unit&) const {}
    __device__ __forceinline__ void done(const Unit&) const {}
};

__device__ __forceinline__ unsigned cvt_pk_bf16(float lo, float hi) { unsigned r; asm volatile("v_cvt_pk_bf16_f32 %0, %1, %2" : "=v"(r) : "v"(lo), "v"(hi)); return r; }
typedef float f32x2 __attribute__((ext_vector_type(2)));
constexpr int XD = 1024;
__device__ __forceinline__ float row_rstd(const float* SS, int r) {
    const f32x4* p = (const f32x4*)(SS + (size_t)r * 16);
    const f32x4 a = p[0], b = p[1], c = p[2], d = p[3];
    const float s = ((a[0] + a[1]) + (a[2] + a[3])) + ((b[0] + b[1]) + (b[2] + b[3])) + ((c[0] + c[1]) + (c[2] + c[3])) + ((d[0] + d[1]) + (d[2] + d[3]));
    return __builtin_amdgcn_rsqf(s * (1.0f / 1024.0f) + 1e-6f);
}
__device__ __forceinline__ float row_rstd32(const float* SSS, int sr) {
    const f32x4* p = (const f32x4*)(SSS + (size_t)sr * 32); float s = 0.f;
#pragma unroll
    for (int j = 0; j < 8; ++j) { const f32x4 a = p[j]; s += (a[0] + a[1]) + (a[2] + a[3]); }
    return __builtin_amdgcn_rsqf(s * (1.0f / 1024.0f) + 1e-6f);
}
__device__ __forceinline__ float any_rstd(const float* SS, const float* SSS, int r) { return r < 16384 ? row_rstd(SS, r) : (r < 16512 ? row_rstd32(SSS, r - 16384) : 1.0f); }
constexpr int RS_TAB_OFF = 131072;
template <class Sched>
__device__ __forceinline__ void fill_rstd_table(PG8_LAS unsigned char* ldsbase, const Sched& S, const float* SS, const float* SSS) {
    int tid_ = threadIdx.x; asm volatile("" : "+v"(tid_));
    const int row = tid_ & 255, half = tid_ >> 8;
    PG8_LAS float* tab = (PG8_LAS float*)(ldsbase + RS_TAB_OFF);
    Unit un[4]; bool ok[4]; f32x4 v[4][4];
#pragma unroll
    for (int j = 0; j < 4; ++j) { ok[j] = S.next(2 * j + half, un[j]); int r = ok[j] ? un[j].pm * BM + row : 0; r = r < 16384 ? r : 16383;
        const f32x4* p = (const f32x4*)(SS + (size_t)r * 16);
#pragma unroll
        for (int q = 0; q < 4; ++q) v[j][q] = p[q]; }
#pragma unroll
    for (int j = 0; j < 4; ++j) { float s = 0.f;
#pragma unroll
        for (int q = 0; q < 4; ++q) s += (v[j][q][0] + v[j][q][1]) + (v[j][q][2] + v[j][q][3]);
        float rs = __builtin_amdgcn_rsqf(s * (1.0f / 1024.0f) + 1e-6f);
        if (ok[j] && un[j].pm >= 64) { const int r = un[j].pm * BM + row; rs = r < 16512 ? row_rstd32(SSS, r - 16384) : 1.0f; }
        if (ok[j]) tab[(2 * j + half) * 256 + row] = rs; }
    __syncthreads();
}
__device__ __forceinline__ float silu_f(float x) { return x * __builtin_amdgcn_rcpf(1.0f + __builtin_amdgcn_exp2f(-1.4426950408889634f * x)); }
__device__ __forceinline__ float gelu_tanh_f(float x) {
    const float a = x * (1.0f + 0.044715f * x * x) * (-2.0f * 0.7978845608028654f * 1.4426950408889634f);
    return x * __builtin_amdgcn_rcpf(1.0f + __builtin_amdgcn_exp2f(a));
}
struct EpiSwiglu {
    static constexpr bool PERM = true, AFTER_DRAIN = false;
    bf16_t* H; const PG8_LAS float* tab; int ldh;
    __device__ __forceinline__ void operator()(const f32x4 (&acc)[2][2][4][2], const Unit& u, int wr, int wc, int fr, int fq) const {
        const int row0 = u.pm * BM + wr * 64 + fr, col0 = u.pn * HALF + wc * 32 + 8 * fq;
        float rsv[2][4];
#pragma unroll
        for (int ai = 0; ai < 2; ++ai)
#pragma unroll
            for (int m = 0; m < 4; ++m) rsv[ai][m] = tab[u.slot * 256 + ((row0 + ai * HALF + m * 16) & 255)];
#pragma unroll
        for (int ai = 0; ai < 2; ++ai)
#pragma unroll
            for (int m = 0; m < 4; ++m) { const int r = row0 + ai * HALF + m * 16; const float rs = rsv[ai][m];
                const float k1 = rs * -1.4426950408889634f, ir2 = __builtin_amdgcn_rcpf(rs * rs);
                float h[8], t[8];
#pragma unroll
                for (int i = 0; i < 8; ++i) t[i] = acc[ai][0][m][i >> 2][i & 3] * k1;
#pragma unroll
                for (int i = 0; i < 8; ++i) h[i] = acc[ai][0][m][i >> 2][i & 3] * acc[ai][1][m][i >> 2][i & 3];
                __builtin_amdgcn_sched_barrier(0);
#pragma unroll
                for (int i = 0; i < 8; ++i) t[i] = __builtin_amdgcn_exp2f(t[i]);
                __builtin_amdgcn_sched_barrier(0);
#pragma unroll
                for (int i = 0; i < 8; ++i) t[i] = __builtin_fmaf(t[i], ir2, ir2);
                __builtin_amdgcn_sched_barrier(0);
#pragma unroll
                for (int i = 0; i < 8; ++i) t[i] = __builtin_amdgcn_rcpf(t[i]);
                __builtin_amdgcn_sched_barrier(0);
#pragma unroll
                for (int i = 0; i < 8; ++i) h[i] *= t[i];
                u32x4 w; w.x = cvt_pk_bf16(h[0], h[1]); w.y = cvt_pk_bf16(h[2], h[3]); w.z = cvt_pk_bf16(h[4], h[5]); w.w = cvt_pk_bf16(h[6], h[7]);
                *(u32x4*)(H + (size_t)r * ldh + col0) = w;
#ifdef PROBE_ST2
                { __attribute__((address_space(1))) u32x4* p2 = (__attribute__((address_space(1))) u32x4*)(H + (size_t)r * ldh + col0); asm volatile("" : "+v"(p2) :: "memory"); *p2 = w; }
#endif
 }
    }
};
struct EpiResid {
    static constexpr bool PERM = true, AFTER_DRAIN = false;
    float* X; bf16_t* XB; float* SS; float scale;
    __device__ __forceinline__ void operator()(const f32x4 (&acc)[2][2][4][2], const Unit& u, int wr, int wc, int fr, int fq) const {
        const int row0 = u.pm * BM + wr * 64 + fr, col0 = u.pn * BM + wc * 32 + 8 * fq;
        const unsigned voff = (unsigned)(row0 * XD + col0) * 2u; char* const xbase = (char*)XB;
        u32x4 xo[2][4][2];
#pragma unroll
        for (int ai = 0; ai < 2; ++ai)
#pragma unroll
            for (int m = 0; m < 4; ++m)
#pragma unroll
                for (int bj = 0; bj < 2; ++bj) xo[ai][m][bj] = *(const u32x4*)(xbase + (voff + (unsigned)(((ai * HALF + m * 16) * XD + bj * HALF) * 2)));
        asm volatile("" ::: "memory");
        float ssv[2][4];
#pragma unroll
        for (int ai = 0; ai < 2; ++ai)
#pragma unroll
            for (int m = 0; m < 4; ++m) { float ss = 0.f;
#pragma unroll
                for (int bj = 0; bj < 2; ++bj) { const unsigned off = voff + (unsigned)(((ai * HALF + m * 16) * XD + bj * HALF) * 2);
                    const u32x4 o = xo[ai][m][bj];
                    f32x4 xa, xb; xa[0] = __builtin_bit_cast(float, o.x << 16); xa[1] = __builtin_bit_cast(float, o.x & 0xffff0000u); xa[2] = __builtin_bit_cast(float, o.y << 16); xa[3] = __builtin_bit_cast(float, o.y & 0xffff0000u);
                    xb[0] = __builtin_bit_cast(float, o.z << 16); xb[1] = __builtin_bit_cast(float, o.z & 0xffff0000u); xb[2] = __builtin_bit_cast(float, o.w << 16); xb[3] = __builtin_bit_cast(float, o.w & 0xffff0000u);
                    xa = xa + acc[ai][bj][m][0] * scale; xb = xb + acc[ai][bj][m][1] * scale;
                    u32x4 w; w.x = cvt_pk_bf16(xa[0], xa[1]); w.y = cvt_pk_bf16(xa[2], xa[3]); w.z = cvt_pk_bf16(xb[0], xb[1]); w.w = cvt_pk_bf16(xb[2], xb[3]); *(u32x4*)(xbase + off) = w;
                    const float y0 = __builtin_bit_cast(float, w.x << 16), y1 = __builtin_bit_cast(float, w.x & 0xffff0000u), y2 = __builtin_bit_cast(float, w.y << 16), y3 = __builtin_bit_cast(float, w.y & 0xffff0000u);
                    const float y4 = __builtin_bit_cast(float, w.z << 16), y5 = __builtin_bit_cast(float, w.z & 0xffff0000u), y6 = __builtin_bit_cast(float, w.w << 16), y7 = __builtin_bit_cast(float, w.w & 0xffff0000u);
                    ss += ((y0 * y0 + y1 * y1) + (y2 * y2 + y3 * y3)) + ((y4 * y4 + y5 * y5) + (y6 * y6 + y7 * y7)); }
                ss += __shfl_xor(ss, 16); ss += __shfl_xor(ss, 32); ssv[ai][m] = ss; }
#pragma unroll
        for (int ai = 0; ai < 2; ++ai) { const float sel = fq == 0 ? ssv[ai][0] : (fq == 1 ? ssv[ai][1] : (fq == 2 ? ssv[ai][2] : ssv[ai][3]));
            SS[(size_t)(row0 + ai * HALF + fq * 16) * 16 + u.pn * 4 + wc] = sel; }
    }
};
struct EpiQkv {
    static constexpr bool PERM = true, AFTER_DRAIN = false;
    bf16_t* QKV; const PG8_LAS float* tab; float* out; int li;
    __device__ __forceinline__ void operator()(const f32x4 (&acc)[2][2][4][2], const Unit& u, int wr, int wc, int fr, int fq) const {
        const int pm = __builtin_amdgcn_readfirstlane(u.pm), pn = __builtin_amdgcn_readfirstlane(u.pn), wrs = __builtin_amdgcn_readfirstlane(wr), wcs = __builtin_amdgcn_readfirstlane(wc);
        const int row0 = pm * BM + wrs * 64 + fr, dl = (wcs & 1) * 32 + 8 * fq;
        float rsv[2][4];
#pragma unroll
        for (int ai = 0; ai < 2; ++ai)
#pragma unroll
            for (int m = 0; m < 4; ++m) rsv[ai][m] = tab[u.slot * 256 + ((row0 + ai * HALF + m * 16) & 255)];
        int secv[2], gv[2], hhv[2];
#pragma unroll
        for (int bj = 0; bj < 2; ++bj) { const int cw = pn * BM + bj * HALF + wcs * 32, sec = cw / 1536, cc = cw - sec * 1536; secv[bj] = sec; gv[bj] = cc >> 9; hhv[bj] = (cc >> 6) & 7; }
        if (pm < 64) {
            const int b = pm >> 4, tb = (pm & 15) * BM + wrs * 64;
#pragma unroll
            for (int ai = 0; ai < 2; ++ai)
#pragma unroll
                for (int m = 0; m < 4; ++m) { const int ts = tb + ai * HALF + m * 16, t = ts + fr; const float rs = rsv[ai][m];
#pragma unroll
                    for (int bj = 0; bj < 2; ++bj) { const int sec = secv[bj], g = gv[bj], hh = hhv[bj], sh = 2 * g;
                        const f32x4 v0 = acc[ai][bj][m][0] * rs, v1 = acc[ai][bj][m][1] * rs;
                        u32x4 w; w.x = cvt_pk_bf16(v0[0], v0[1]); w.y = cvt_pk_bf16(v0[2], v0[3]); w.z = cvt_pk_bf16(v1[0], v1[1]); w.w = cvt_pk_bf16(v1[2], v1[3]);
                        const int uu = ((t & ((1 << sh) - 1)) << (12 - sh)) + (t >> sh);
                        *(u32x4*)(QKV + ((size_t)(((sec * 4 + b) * 3 + g) * 8 + hh) * 4096) * 64 + (size_t)(uu * 64 + dl)) = w;
                        if (sec > 0) { const int keep = 128 << sh, i0 = ts - (4096 - keep);
                            if (i0 >= 0) { const size_t obase = g == 0 ? 16908288u : (g == 1 ? 17956864u : 22151168u);
                                float* dst = out + obase + ((((size_t)(li * 4 + b) * keep + i0) * 2 + (sec - 1)) * 8 + hh) * 64 + (size_t)(fr * 1024 + dl);
                                *(f32x4*)dst = v0; *(f32x4*)(dst + 4) = v1; } } } }
        } else {
#pragma unroll
            for (int ai = 0; ai < 2; ++ai)
#pragma unroll
                for (int m = 0; m < 4; ++m) { const int r = row0 + ai * HALF + m * 16; const float rs = rsv[ai][m];
#pragma unroll
                    for (int bj = 0; bj < 2; ++bj) { const int sec = secv[bj], g = gv[bj], hh = hhv[bj];
                        const f32x4 v0 = acc[ai][bj][m][0] * rs, v1 = acc[ai][bj][m][1] * rs;
                        u32x4 w; w.x = cvt_pk_bf16(v0[0], v0[1]); w.y = cvt_pk_bf16(v0[2], v0[3]); w.z = cvt_pk_bf16(v1[0], v1[1]); w.w = cvt_pk_bf16(v1[2], v1[3]);
                        *(u32x4*)(QKV + (size_t)r * 4608 + (pn * BM + bj * HALF + wcs * 32 + 8 * fq)) = w;
                        if (sec > 0 && ai == 0) { const int sr = wrs * 64 + m * 16 + fr;
                            const size_t obase = g == 0 ? 38928384u : (g == 1 ? 39190528u : 39452672u);
                            float* dst = out + obase + (((size_t)(li * 128) * 2 + (sec - 1)) * 8 + hh) * 64 + (size_t)(sr * 1024 + dl);
                            *(f32x4*)dst = v0; *(f32x4*)(dst + 4) = v1; } } }
        }
    }
};
struct EpiUv {
    static constexpr bool PERM = true, AFTER_DRAIN = false;
    bf16_t* UV; const PG8_LAS float* tab; float* VS;
    __device__ __forceinline__ void operator()(const f32x4 (&acc)[2][2][4][2], const Unit& u, int wr, int wc, int fr, int fq) const {
        typedef float f32x2 __attribute__((ext_vector_type(2)));
        const int row0 = u.pm * BM + wr * 64 + fr; const bool vhalf = u.pn >= 12;
        float rsv[2][4], sv1[2][4], sv2[2][4];
#pragma unroll
        for (int ai = 0; ai < 2; ++ai)
#pragma unroll
            for (int m = 0; m < 4; ++m) rsv[ai][m] = tab[u.slot * 256 + ((row0 + ai * HALF + m * 16) & 255)];
#pragma unroll
        for (int ai = 0; ai < 2; ++ai)
#pragma unroll
            for (int m = 0; m < 4; ++m) { const int r = row0 + ai * HALF + m * 16; const float rs = rsv[ai][m]; float s1 = 0.f, s2 = 0.f;
                const float C0 = -2.0f * 0.7978845608028654f * 1.4426950408889634f, K0 = C0 * rs, K1 = (C0 * 0.044715f) * rs * rs * rs, irs = __builtin_amdgcn_rcpf(rs);
#pragma unroll
                for (int bj = 0; bj < 2; ++bj) { const int c0 = u.pn * BM + bj * HALF + wc * 32 + 8 * fq; float h[8], t[8];
#pragma unroll
                    for (int i = 0; i < 8; ++i) t[i] = acc[ai][bj][m][i >> 2][i & 3] * acc[ai][bj][m][i >> 2][i & 3];
#pragma unroll
                    for (int i = 0; i < 8; ++i) t[i] = __builtin_fmaf(t[i], K1, K0);
#pragma unroll
                    for (int i = 0; i < 8; ++i) t[i] *= acc[ai][bj][m][i >> 2][i & 3];
                    __builtin_amdgcn_sched_barrier(0);
#pragma unroll
                    for (int i = 0; i < 8; ++i) t[i] = __builtin_amdgcn_exp2f(t[i]);
                    __builtin_amdgcn_sched_barrier(0);
#pragma unroll
                    for (int i = 0; i < 8; ++i) t[i] = __builtin_fmaf(t[i], irs, irs);
                    __builtin_amdgcn_sched_barrier(0);
#pragma unroll
                    for (int i = 0; i < 8; ++i) t[i] = __builtin_amdgcn_rcpf(t[i]);
                    __builtin_amdgcn_sched_barrier(0);
#pragma unroll
                    for (int i = 0; i < 8; ++i) h[i] = acc[ai][bj][m][i >> 2][i & 3] * t[i];
                    if (vhalf) {
#pragma unroll
                        for (int i = 0; i < 8; ++i) { s1 += h[i]; s2 = __builtin_fmaf(h[i], h[i], s2); } }
                    u32x4 w; w.x = cvt_pk_bf16(h[0], h[1]); w.y = cvt_pk_bf16(h[2], h[3]); w.z = cvt_pk_bf16(h[4], h[5]); w.w = cvt_pk_bf16(h[6], h[7]);
                    *(u32x4*)(UV + (size_t)r * 6144 + c0) = w; }
                if (vhalf) { s1 += __shfl_xor(s1, 16); s1 += __shfl_xor(s1, 32); s2 += __shfl_xor(s2, 16); s2 += __shfl_xor(s2, 32); }
                sv1[ai][m] = s1; sv2[ai][m] = s2; }
        if (vhalf) {
#pragma unroll
            for (int ai = 0; ai < 2; ++ai) { const float a1 = fq == 0 ? sv1[ai][0] : (fq == 1 ? sv1[ai][1] : (fq == 2 ? sv1[ai][2] : sv1[ai][3])), a2 = fq == 0 ? sv2[ai][0] : (fq == 1 ? sv2[ai][1] : (fq == 2 ? sv2[ai][2] : sv2[ai][3]));
                *(f32x2*)(VS + ((size_t)(row0 + ai * HALF + fq * 16) * 48 + (u.pn - 12) * 4 + wc) * 2) = (f32x2){a1, a2}; } }
    }
};
template <class Epi, class Sched, bool ALIGN_EPI = false, bool SP2 = false>
__device__ __forceinline__ void gemm_phase(PG8_LAS unsigned char* lds, const Gemm g, const Sched& S, const Epi& E, const bool preB = false) {
    int tid_ = threadIdx.x; asm volatile("" : "+v"(tid_));
    const int tid = tid_, wid = __builtin_amdgcn_readfirstlane(tid >> 6), lane = tid & 63, wr = wid >> 2, wc = wid & 3, fr = lane & 15, fq = lane >> 4;
    const int K = g.K, nt = K / BK;
    unsigned voffA[2], voffB[2];
#pragma unroll
    for (int i = 0; i < 2; ++i) { int R, C; stage_rc(tid * 16 + i * 8192, R, C); const int Rb = Epi::PERM ? ((R & ~31) + perm32(R & 31)) : R;
        voffA[i] = (unsigned)(R * K + C) * 2u; voffB[i] = (unsigned)(Rb * K + C) * 2u; }
    const size_t kstep = (size_t)(BK * 2);
    const size_t hstep = (size_t)HALF * K * 2;
    const size_t tstep = 2 * hstep;
    const unsigned ldsw = (unsigned)wid * 1024u;
    const int aoff = lds_byte(wr * 64 + fr, fq * 8), boff = lds_byte(wc * 32 + fr, fq * 8);
#define PG8_SA(b, h) (((b) * 2 + (h)) * HTB)
#define PG8_SB(b, h) ((4 + (b) * 2 + (h)) * HTB)
#define PG8_STAGE(bufoff, gbase, voff) do { _Pragma("unroll") for (int _i = 0; _i < 2; ++_i) { \
        const unsigned _m0 = (unsigned)__builtin_amdgcn_readfirstlane((int)(unsigned)(__UINTPTR_TYPE__)(lds + (bufoff) + ldsw + _i * 8192)); \
        asm volatile("s_mov_b32 m0, %2\n\ts_nop 0\n\tglobal_load_lds_dwordx4 %0, %1" :: "v"((voff)[_i]), "s"((const char*)(gbase)), "s"(_m0) : "memory"); } } while (0)
#define PG8_LDA(dst, b, h) do { _Pragma("unroll") for (int m = 0; m < 4; ++m) _Pragma("unroll") for (int k = 0; k < 2; ++k) dst[m][k] = *(const PG8_LAS bf16x8*)(lds + PG8_SA(b, h) + aoff + m * 2048 + k * 512); } while (0)
#define PG8_LDB(dst, b, h) do { _Pragma("unroll") for (int n = 0; n < 2; ++n) _Pragma("unroll") for (int k = 0; k < 2; ++k) dst[n][k] = *(const PG8_LAS bf16x8*)(lds + PG8_SB(b, h) + boff + n * 2048 + k * 512); } while (0)
#define PG8_MMA(ai, bj, At, Bt) do { _Pragma("unroll") for (int m = 0; m < 4; ++m) _Pragma("unroll") for (int n = 0; n < 2; ++n) _Pragma("unroll") for (int k = 0; k < 2; ++k) \
        acc[ai][bj][m][n] = __builtin_amdgcn_mfma_f32_16x16x32_bf16(Bt[n][k], At[m][k], acc[ai][bj][m][n], 0, 0, 0); } while (0)
#define PG8_MMAZ(ai, bj, At, Bt) do { _Pragma("unroll") for (int m = 0; m < 4; ++m) _Pragma("unroll") for (int n = 0; n < 2; ++n) { \
        acc[ai][bj][m][n] = __builtin_amdgcn_mfma_f32_16x16x32_bf16(Bt[n][0], At[m][0], (f32x4){0.f, 0.f, 0.f, 0.f}, 0, 0, 0); acc[ai][bj][m][n] = __builtin_amdgcn_mfma_f32_16x16x32_bf16(Bt[n][1], At[m][1], acc[ai][bj][m][n], 0, 0, 0); } } while (0)
#define PG8_PRIO(x) __builtin_amdgcn_s_setprio(x)
#define PG8_WAIT_V(n) asm volatile("s_waitcnt vmcnt(" #n ")" ::: "memory")
#define PG8_WAIT_L(n) asm volatile("s_waitcnt lgkmcnt(" #n ")" ::: "memory")
#define PG8_BAR __builtin_amdgcn_s_barrier()
#define PG8_SCHED __builtin_amdgcn_sched_barrier(0)
    Unit cur, nxt; int ui = 0;
    if (!S.next(0, cur)) return;
    f32x4 acc[2][2][4][2];
    if constexpr (!SP2) {
#pragma unroll
    for (int a = 0; a < 2; ++a)
#pragma unroll
        for (int b = 0; b < 2; ++b)
#pragma unroll
            for (int m = 0; m < 4; ++m)
#pragma unroll
                for (int n = 0; n < 2; ++n) acc[a][b][m][n] = (f32x4){0.f, 0.f, 0.f, 0.f};
    }
    bf16x8 At[4][2], B0[2][2], B1[2][2];
    const char* cA = (const char*)g.A + (size_t)cur.pm * tstep; const char* cB = (const char*)g.Bt + (size_t)cur.pn * tstep;
    S.a_ready(cur);
    if constexpr (SP2) {
        if (!preB) { PG8_STAGE(PG8_SB(0, 0), cB, voffB); PG8_STAGE(PG8_SB(0, 1), cB + hstep, voffB); }
        PG8_STAGE(PG8_SA(0, 0), cA, voffA); PG8_STAGE(PG8_SA(0, 1), cA + hstep, voffA);
        if (wr == 1) PG8_BAR;
        PG8_WAIT_V(2); PG8_BAR;
        if (!preB) { PG8_STAGE(PG8_SB(1, 0), cB + kstep, voffB); PG8_STAGE(PG8_SA(1, 0), cA + kstep, voffA); PG8_STAGE(PG8_SB(1, 1), cB + hstep + kstep, voffB);
            PG8_WAIT_V(6); }
        else { PG8_STAGE(PG8_SA(1, 0), cA + kstep, voffA); PG8_WAIT_V(2); }
        PG8_BAR;
    } else {
        PG8_STAGE(PG8_SB(0, 0), cB, voffB); PG8_STAGE(PG8_SA(0, 0), cA, voffA); PG8_STAGE(PG8_SB(0, 1), cB + hstep, voffB); PG8_STAGE(PG8_SA(0, 1), cA + hstep, voffA);
        if (wr == 1) PG8_BAR;
        PG8_WAIT_V(4); PG8_BAR;
        PG8_STAGE(PG8_SB(1, 0), cB + kstep, voffB); PG8_STAGE(PG8_SA(1, 0), cA + kstep, voffA); PG8_STAGE(PG8_SB(1, 1), cB + hstep + kstep, voffB);
        PG8_WAIT_V(6); PG8_BAR;
    }
    for (;;) {
        const bool has_next = S.next(ui + 1, nxt);
        const char* nA = has_next ? (const char*)g.A + (size_t)nxt.pm * tstep : cA; const char* nB = has_next ? (const char*)g.Bt + (size_t)nxt.pn * tstep : cB;
        const int nt_main = (SP2 && !has_next) ? nt - 2 : nt;
        if constexpr (SP2) {
            const char* a1 = cA + kstep; const char* a2 = cA + 2 * kstep; const char* b2 = cB + 2 * kstep; const char* a3 = a2 + kstep; const char* b3 = b2 + kstep;
            PG8_LDB(B0, 0, 0); PG8_LDB(B1, 0, 1); PG8_SCHED; PG8_LDA(At, 0, 0); PG8_STAGE(PG8_SA(1, 1), a1 + hstep, voffA);
            PG8_WAIT_V(8); PG8_WAIT_L(0); PG8_BAR; PG8_PRIO(1); PG8_MMAZ(0, 0, At, B0); PG8_MMAZ(0, 1, At, B1); PG8_PRIO(0); PG8_BAR; PG8_SCHED;
            PG8_LDA(At, 0, 1); PG8_STAGE(PG8_SB(0, 0), b2, voffB); PG8_STAGE(PG8_SB(0, 1), b2 + hstep, voffB); PG8_STAGE(PG8_SA(0, 0), a2, voffA);
            PG8_WAIT_V(8); PG8_WAIT_L(0); PG8_BAR; PG8_PRIO(1); PG8_MMAZ(1, 0, At, B0); PG8_MMAZ(1, 1, At, B1); PG8_PRIO(0); PG8_BAR; PG8_SCHED;
            PG8_LDB(B0, 1, 0); PG8_LDB(B1, 1, 1); PG8_SCHED; PG8_LDA(At, 1, 0); PG8_STAGE(PG8_SA(0, 1), a2 + hstep, voffA);
            PG8_WAIT_V(8); PG8_WAIT_L(0); PG8_BAR; PG8_PRIO(1); PG8_MMA(0, 0, At, B0); PG8_MMA(0, 1, At, B1); PG8_PRIO(0); PG8_BAR; PG8_SCHED;
            PG8_LDA(At, 1, 1); PG8_STAGE(PG8_SB(1, 0), b3, voffB); PG8_STAGE(PG8_SB(1, 1), b3 + hstep, voffB); PG8_STAGE(PG8_SA(1, 0), a3, voffA);
            PG8_WAIT_V(8); PG8_WAIT_L(0); PG8_BAR; PG8_PRIO(1); PG8_MMA(1, 0, At, B0); PG8_MMA(1, 1, At, B1); PG8_PRIO(0); PG8_BAR; PG8_SCHED;
        }
        for (int t = SP2 ? 2 : 0; t < nt_main; t += 2) {
            const bool last = (t == nt - 2);
            const char* a1 = cA + (size_t)(t + 1) * kstep;
            const char* a2 = last ? nA : cA + (size_t)(t + 2) * kstep; const char* b2 = last ? nB : cB + (size_t)(t + 2) * kstep;
            const char* a3 = a2 + kstep; const char* b3 = b2 + kstep;
            if (last && has_next) S.a_ready(nxt);
            if constexpr (SP2) {
            PG8_LDB(B0, 0, 0); PG8_LDB(B1, 0, 1); PG8_SCHED; PG8_LDA(At, 0, 0); PG8_STAGE(PG8_SA(1, 1), a1 + hstep, voffA);
            PG8_WAIT_V(8); PG8_WAIT_L(0); PG8_BAR; PG8_PRIO(1); PG8_MMA(0, 0, At, B0); PG8_MMA(0, 1, At, B1); PG8_PRIO(0); PG8_BAR; PG8_SCHED;
            PG8_LDA(At, 0, 1); PG8_STAGE(PG8_SB(0, 0), b2, voffB); PG8_STAGE(PG8_SB(0, 1), b2 + hstep, voffB); PG8_STAGE(PG8_SA(0, 0), a2, voffA);
            PG8_WAIT_V(8); PG8_WAIT_L(0); PG8_BAR; PG8_PRIO(1); PG8_MMA(1, 0, At, B0); PG8_MMA(1, 1, At, B1); PG8_PRIO(0); PG8_BAR; PG8_SCHED;
            PG8_LDB(B0, 1, 0); PG8_LDB(B1, 1, 1); PG8_SCHED; PG8_LDA(At, 1, 0); PG8_STAGE(PG8_SA(0, 1), a2 + hstep, voffA);
            PG8_WAIT_V(8); PG8_WAIT_L(0); PG8_BAR; PG8_PRIO(1); PG8_MMA(0, 0, At, B0); PG8_MMA(0, 1, At, B1); PG8_PRIO(0); PG8_BAR; PG8_SCHED;
            PG8_LDA(At, 1, 1); PG8_STAGE(PG8_SB(1, 0), b3, voffB); PG8_STAGE(PG8_SB(1, 1), b3 + hstep, voffB); PG8_STAGE(PG8_SA(1, 0), a3, voffA);
            PG8_WAIT_V(8); PG8_WAIT_L(0); PG8_BAR; PG8_PRIO(1); PG8_MMA(1, 0, At, B0); PG8_MMA(1, 1, At, B1); PG8_PRIO(0); PG8_BAR; PG8_SCHED;
            } else {
            PG8_LDB(B0, 0, 0); PG8_SCHED; PG8_LDA(At, 0, 0); PG8_STAGE(PG8_SA(1, 1), a1 + hstep, voffA);
            PG8_WAIT_L(8); PG8_BAR; PG8_WAIT_L(0); PG8_PRIO(1); PG8_MMA(0, 0, At, B0); PG8_PRIO(0); PG8_BAR; PG8_SCHED;
            PG8_LDB(B1, 0, 1); PG8_STAGE(PG8_SB(0, 0), b2, voffB);
            PG8_BAR; PG8_WAIT_L(0); PG8_PRIO(1); PG8_MMA(0, 1, At, B1); PG8_PRIO(0); PG8_BAR;
            PG8_LDA(At, 0, 1); PG8_STAGE(PG8_SA(0, 0), a2, voffA);
            PG8_BAR; PG8_WAIT_L(0); PG8_PRIO(1); PG8_MMA(1, 0, At, B0); PG8_PRIO(0); PG8_BAR; PG8_SCHED;
            PG8_STAGE(PG8_SB(0, 1), b2 + hstep, voffB);
            PG8_WAIT_V(6); PG8_BAR; PG8_PRIO(1); PG8_MMA(1, 1, At, B1); PG8_PRIO(0); PG8_BAR;
            PG8_LDB(B0, 1, 0); PG8_SCHED; PG8_LDA(At, 1, 0); PG8_STAGE(PG8_SA(0, 1), a2 + hstep, voffA);
            PG8_WAIT_L(8); PG8_BAR; PG8_WAIT_L(0); PG8_PRIO(1); PG8_MMA(0, 0, At, B0); PG8_PRIO(0); PG8_BAR; PG8_SCHED;
            PG8_LDB(B1, 1, 1); PG8_STAGE(PG8_SB(1, 0), b3, voffB);
            PG8_BAR; PG8_WAIT_L(0); PG8_PRIO(1); PG8_MMA(0, 1, At, B1); PG8_PRIO(0); PG8_BAR;
            PG8_LDA(At, 1, 1); PG8_STAGE(PG8_SA(1, 0), a3, voffA);
            PG8_BAR; PG8_WAIT_L(0); PG8_PRIO(1); PG8_MMA(1, 0, At, B0); PG8_PRIO(0); PG8_BAR; PG8_SCHED;
            PG8_STAGE(PG8_SB(1, 1), b3 + hstep, voffB);
            PG8_WAIT_V(6); PG8_BAR; PG8_PRIO(1); PG8_MMA(1, 1, At, B1); PG8_PRIO(0); PG8_BAR;
            }
        }
        if constexpr (SP2) { if (!has_next) { const char* a1 = cA + (size_t)(nt - 1) * kstep;
            PG8_LDB(B0, 0, 0); PG8_LDB(B1, 0, 1); PG8_SCHED; PG8_LDA(At, 0, 0); PG8_STAGE(PG8_SA(1, 1), a1 + hstep, voffA);
            PG8_WAIT_V(8); PG8_WAIT_L(0); PG8_BAR; PG8_PRIO(1); PG8_MMA(0, 0, At, B0); PG8_MMA(0, 1, At, B1); PG8_PRIO(0); PG8_BAR; PG8_SCHED;
            PG8_LDA(At, 0, 1);
            PG8_WAIT_V(2); PG8_WAIT_L(0); PG8_BAR; PG8_PRIO(1); PG8_MMA(1, 0, At, B0); PG8_MMA(1, 1, At, B1); PG8_PRIO(0); PG8_BAR; PG8_SCHED;
            PG8_LDB(B0, 1, 0); PG8_LDB(B1, 1, 1); PG8_SCHED; PG8_LDA(At, 1, 0);
            PG8_WAIT_V(0); PG8_WAIT_L(0); PG8_BAR; PG8_PRIO(1); PG8_MMA(0, 0, At, B0); PG8_MMA(0, 1, At, B1); PG8_PRIO(0); PG8_BAR; PG8_SCHED;
            PG8_LDA(At, 1, 1);
            PG8_WAIT_L(0); PG8_BAR; PG8_PRIO(1); PG8_MMA(1, 0, At, B0); PG8_MMA(1, 1, At, B1); PG8_PRIO(0); PG8_BAR; PG8_SCHED;
        } }
        if constexpr (ALIGN_EPI) { if (wr == 0) PG8_BAR; }
        if constexpr (!Epi::AFTER_DRAIN) { E(acc, cur, wr, wc, fr, fq); S.done(cur); }
        if (!has_next) break;
        if constexpr (!SP2) {
#pragma unroll
        for (int a = 0; a < 2; ++a)
#pragma unroll
            for (int b = 0; b < 2; ++b)
#pragma unroll
                for (int m = 0; m < 4; ++m)
#pragma unroll
                    for (int n = 0; n < 2; ++n) acc[a][b][m][n] = (f32x4){0.f, 0.f, 0.f, 0.f};
        }
        cur = nxt; cA = nA; cB = nB; ++ui;
        if constexpr (ALIGN_EPI) { if (wr == 1) PG8_BAR; }
    }
    PG8_WAIT_V(0);
    if constexpr (!ALIGN_EPI) { if (wr == 0) PG8_BAR; }
    PG8_BAR;
    if constexpr (Epi::AFTER_DRAIN) { E.fused(acc, cur, wr, wc, fr, fq, lds, wid, lane); S.done(cur); }
#undef PG8_SA
#undef PG8_SB
#undef PG8_STAGE
#undef PG8_LDA
#undef PG8_LDB
#undef PG8_MMA
#undef PG8_PRIO
#undef PG8_MMAZ
#undef PG8_WAIT_V
#undef PG8_WAIT_L
#undef PG8_BAR
#undef PG8_SCHED
}
template <bool PERM, class Sched>
__device__ __forceinline__ void gemm_prefetch_b(PG8_LAS unsigned char* lds, const bf16_t* Bt, int K, const Sched& S, const int part) {
    int tid_ = threadIdx.x; asm volatile("" : "+v"(tid_));
    const int tid = tid_, wid = __builtin_amdgcn_readfirstlane(tid >> 6);
    if ((wid == 0) != (part == 1)) return;
    Unit cur; if (!S.next(0, cur)) return;
    const size_t hstep = (size_t)HALF * K * 2; const char* cB = (const char*)Bt + (size_t)cur.pn * 2 * hstep;
#pragma unroll
    for (int i = 0; i < 2; ++i) { int R, C; stage_rc(tid * 16 + i * 8192, R, C); const int Rb = PERM ? ((R & ~31) + perm32(R & 31)) : R; const unsigned vo = (unsigned)(Rb * K + C) * 2u;
#pragma unroll
        for (int b = 0; b < 2; ++b)
#pragma unroll
            for (int h = 0; h < 2; ++h)
                __builtin_amdgcn_global_load_lds((const unsigned*)(cB + (size_t)h * hstep + (size_t)b * (BK * 2) + vo), (PG8_LAS unsigned*)(lds + (4 + b * 2 + h) * HTB + (unsigned)wid * 1024u + i * 8192), 16, 0, 0); }
}
}
#define GAS __attribute__((address_space(1)))
#define LAS __attribute__((address_space(3)))
typedef unsigned short bf16;
typedef unsigned v4u __attribute__((ext_vector_type(4)));
typedef float f32x4 __attribute__((ext_vector_type(4)));
typedef short bf16x8 __attribute__((ext_vector_type(8)));
typedef GAS unsigned gu32;
typedef GAS unsigned long long gu64;
#define RLX_AGENT __ATOMIC_RELAXED, __HIP_MEMORY_SCOPE_AGENT
#define LDS_WAIT() asm volatile("s_waitcnt lgkmcnt(0)" ::: "memory")
#define VM_WAIT() asm volatile("s_waitcnt vmcnt(0)" ::: "memory")
__device__ __forceinline__ unsigned long long rt() { return __builtin_amdgcn_s_memrealtime(); }
__device__ __forceinline__ unsigned f2bf(float f) { unsigned u = __builtin_bit_cast(unsigned, f); return (u + 0x7fffu + ((u >> 16) & 1u)) >> 16; }
__device__ __forceinline__ unsigned pk2(float lo, float hi) { return f2bf(lo) | (f2bf(hi) << 16); }

#define XB_TMO      128
#define XB_XCNT(j)  (256  + 64 * (j))
#define XB_XSUB(j)  (1280 + 64 * (j))
#define XB_XGEN(j)  (2304 + 64 * (j))
#define XB_TOP      3328
#define XB_TOPGEN   3392
#define XCD_BAR_WORDS 3456
#define XB_SPIN_CAP (1u << 18)

__device__ __forceinline__ unsigned xb_ld(unsigned* p)              { return __hip_atomic_load(p, __ATOMIC_RELAXED, __HIP_MEMORY_SCOPE_AGENT); }
__device__ __forceinline__ unsigned xb_add(unsigned* p, unsigned v) { return __hip_atomic_fetch_add(p, v, __ATOMIC_RELAXED, __HIP_MEMORY_SCOPE_AGENT); }
__device__ __forceinline__ unsigned xb_xcc_id() { return (unsigned)__builtin_amdgcn_s_getreg((3 << 11) | 20) & 0xFu; }
#define XB_SPIN(cond, bar) do { unsigned _sp = 0; while (cond) { __builtin_amdgcn_s_sleep(1); \
    if ((++_sp & 255u) == 0u) { if (xb_ld(&(bar)[XB_TMO])) break; if (_sp > XB_SPIN_CAP) { atomicAdd(&(bar)[XB_TMO], 1u); break; } } } } while (0)

struct XcdBarrier {
    unsigned* bar; unsigned x;
    volatile LAS unsigned* st;
};

__device__ __forceinline__ XcdBarrier xcd_barrier_post(unsigned* bar, volatile LAS unsigned* st) {
    XcdBarrier b; b.bar = bar; b.x = xb_xcc_id(); b.st = st;
    if (threadIdx.x == 0) (void)xb_add(&bar[XB_XCNT(b.x)], 1u);
    return b;
}
__device__ __forceinline__ void xcd_barrier_complete(unsigned* bar, unsigned x, unsigned& nloc, unsigned& nx) {
    const unsigned G = gridDim.x * gridDim.y * gridDim.z;
    unsigned sum, cnt, mine, sp = 0u;
    for (;;) {
        sum = 0u; cnt = 0u; mine = 0u;
#pragma unroll
        for (unsigned j = 0; j < 16; ++j) { const unsigned c = xb_ld(&bar[XB_XCNT(j)]); sum += c; cnt += (c > 0u) ? 1u : 0u; mine = (j == x) ? c : mine; }
        if (sum == G) break;
        __builtin_amdgcn_s_sleep(1);
        if ((++sp & 255u) == 0u) { if (xb_ld(&bar[XB_TMO])) break; if (sp > XB_SPIN_CAP) { atomicAdd(&bar[XB_TMO], 1u); break; } }
    }
    nloc = mine > 0u ? mine : 1u; nx = cnt > 0u ? cnt : 1u;
}

__device__ __forceinline__ void xcd_barrier(const XcdBarrier& b) {
    asm volatile("s_waitcnt vmcnt(0)" ::: "memory");
    __syncthreads();
    if (threadIdx.x == 0) {
        unsigned* bar = b.bar; unsigned bx_ = b.x; asm volatile("" : "+s"(bx_));
        __builtin_amdgcn_s_waitcnt(0);
        unsigned nloc = b.st[0], nx = b.st[1];
        if (nloc == 0u) { xcd_barrier_complete(bar, bx_, nloc, nx); b.st[0] = nloc; b.st[1] = nx; }
        const unsigned old = xb_add(&bar[XB_XSUB(bx_)], 1u);
        const unsigned gen = old / nloc;
        if (old + 1u == (gen + 1u) * nloc) {
            __builtin_amdgcn_fence(__ATOMIC_RELEASE, "agent");
            asm volatile("s_waitcnt vmcnt(0)" ::: "memory");
            const unsigned og = xb_add(&bar[XB_TOP], 1u);
            const unsigned tg = og / nx;
            if (og + 1u == (tg + 1u) * nx) xb_add(&bar[XB_TOPGEN], 1u);
            else XB_SPIN(xb_ld(&bar[XB_TOPGEN]) == tg, bar);
            __builtin_amdgcn_fence(__ATOMIC_ACQUIRE, "agent");
            xb_add(&bar[XB_XGEN(bx_)], 1u);
            asm volatile("s_waitcnt vmcnt(0)" ::: "memory");
        } else {
            XB_SPIN(xb_ld(&bar[XB_XGEN(bx_)]) == gen, bar);
            __builtin_amdgcn_fence(__ATOMIC_ACQUIRE, "agent");
            asm volatile("s_waitcnt vmcnt(0)" ::: "memory");
        }
    }
    __syncthreads();
}
__device__ __forceinline__ void xcd_barrier_head() { asm volatile("s_waitcnt vmcnt(0)" ::: "memory"); __syncthreads(); }
__device__ __forceinline__ void xcd_barrier_tail(const XcdBarrier& b) {
    if (threadIdx.x == 0) {
        unsigned* bar = b.bar; unsigned bx_ = b.x; asm volatile("" : "+s"(bx_));
        __builtin_amdgcn_s_waitcnt(0);
        unsigned nloc = b.st[0], nx = b.st[1];
        if (nloc == 0u) { xcd_barrier_complete(bar, bx_, nloc, nx); b.st[0] = nloc; b.st[1] = nx; }
        const unsigned old = xb_add(&bar[XB_XSUB(bx_)], 1u);
        const unsigned gen = old / nloc;
        if (old + 1u == (gen + 1u) * nloc) {
            __builtin_amdgcn_fence(__ATOMIC_RELEASE, "agent");
            asm volatile("s_waitcnt vmcnt(0)" ::: "memory");
            const unsigned og = xb_add(&bar[XB_TOP], 1u);
            const unsigned tg = og / nx;
            if (og + 1u == (tg + 1u) * nx) xb_add(&bar[XB_TOPGEN], 1u);
            else XB_SPIN(xb_ld(&bar[XB_TOPGEN]) == tg, bar);
            __builtin_amdgcn_fence(__ATOMIC_ACQUIRE, "agent");
            xb_add(&bar[XB_XGEN(bx_)], 1u);
            asm volatile("s_waitcnt vmcnt(0)" ::: "memory");
        } else {
            XB_SPIN(xb_ld(&bar[XB_XGEN(bx_)]) == gen, bar);
            __builtin_amdgcn_fence(__ATOMIC_ACQUIRE, "agent");
            asm volatile("s_waitcnt vmcnt(0)" ::: "memory");
        }
    }
    __syncthreads();
}
constexpr int NWAVES = 8, NTHREADS = 512;
constexpr int DM = 1024, SEQ = 4096, NB = 4, MP = NB * SEQ, SB = 32, ST = 4, MS = SB * ST, MREAL = MP + MS, MROWS = 16640;
constexpr int DFF = 2816, NIN = 2 * DFF, QW = 4608, AW = 512, DV = 3072, UVW = 6144;
constexpr float RMS_EPS = 1e-6f, LN_EPS = 1e-5f;
constexpr size_t O_Y = 0, O_YS = 16777216, O_KV128P = 16908288, O_KV512P = 17956864, O_KV2048P = 22151168, O_KV128S = 38928384, O_KV512S = 39190528, O_KV2048S = 39452672, O_VC = 39714816, O_END = 40501248;
constexpr size_t MiB = 1u << 20;
constexpr size_t WS_CTL = 0, CTL_ZERO_BYTES = 1 * MiB;
constexpr size_t SZ_WIN = (size_t)NIN * DM * 2, SZ_WOUT = (size_t)DM * DFF * 2, SZ_WQKV = (size_t)QW * DM * 2, SZ_WOA = (size_t)DM * AW * 2, SZ_WUV = (size_t)UVW * DM * 2, SZ_WOB = (size_t)DM * DV * 2;
constexpr size_t WS_WIN1 = 1 * MiB, WS_WOUT1 = WS_WIN1 + 4 * SZ_WIN, WS_WIN2 = WS_WOUT1 + 4 * SZ_WOUT, WS_WOUT2 = WS_WIN2 + 4 * SZ_WIN;
constexpr size_t WS_WQKV = WS_WOUT2 + 4 * SZ_WOUT, WS_WOA = WS_WQKV + 2 * SZ_WQKV, WS_WUV = WS_WOA + 2 * SZ_WOA, WS_WOB = WS_WUV + 2 * SZ_WUV;
constexpr size_t WS_X = WS_WOB + 2 * SZ_WOB;
constexpr size_t WS_XB = WS_X + (size_t)MROWS * DM * 4;
constexpr size_t WS_SS = WS_XB + (size_t)MROWS * DM * 2;
constexpr size_t WS_BIG = WS_SS + (size_t)MROWS * 16 * 4;
constexpr size_t WS_YZ = WS_BIG + (size_t)MROWS * UVW * 2;
constexpr size_t WS_WSB = WS_YZ + (size_t)MROWS * DV * 2;
constexpr size_t WS_VS = WS_WSB + (size_t)2 * 8 * 128 * 128 * 2;
constexpr size_t WS_SSS = WS_VS + (size_t)MP * 48 * 2 * 4;
constexpr size_t WS_END = WS_SSS + (size_t)MS * 32 * 4;
static_assert(WS_WIN1 % 256 == 0 && WS_X % 256 == 0 && WS_XB % 256 == 0 && WS_SS % 256 == 0 && WS_BIG % 256 == 0 && WS_YZ % 256 == 0, "alignment");
constexpr int CW_TMO = 0, CW_BAR = 4096;
constexpr int RING_OFF = 0, RING_BYTES = 143360;
constexpr int LDSCTL_OFF = RING_BYTES, MISC_OFF = LDSCTL_OFF + 320;
constexpr int LDS_BYTES = 147456;
struct Args { const float* in[21]; float* out; unsigned char* ws; int ph_lo, ph_hi; };
static_assert(sizeof(Args) == 192, "Args layout");
#define LOCAL_IDS int tid_ = threadIdx.x; asm volatile("" : "+v"(tid_)); const int tid = tid_, lane = tid & 63, wave = __builtin_amdgcn_readfirstlane(tid >> 6); (void)tid; (void)lane; (void)wave
#define CAS __attribute__((address_space(4)))
__device__ __forceinline__ const CAS unsigned char* kargp() { const CAS unsigned char* kp = (const CAS unsigned char*)__builtin_amdgcn_kernarg_segment_ptr(); asm volatile("" : "+s"(kp)); return kp; }
__device__ __forceinline__ const float* kin(int i) { return *(const float* const CAS*)(kargp() + 8 * i); }
__device__ __forceinline__ float* kout() { return *(float* const CAS*)(kargp() + 168); }
__device__ __forceinline__ unsigned char* kws() { return *(unsigned char* const CAS*)(kargp() + 176); }
__device__ __forceinline__ int opq(int v) { asm volatile("" : "+s"(v)); return v; }
struct Frame {
    LAS unsigned char* lds; volatile LAS unsigned* MISC; gu32* ctl;
    int vcu, G;
};
__device__ __forceinline__ float wave_sum(float v) {
#pragma unroll
    for (int o = 1; o < 64; o <<= 1) v += __shfl_xor(v, o);
    return v;
}
__device__ __forceinline__ float wave_max(float v) {
#pragma unroll
    for (int o = 1; o < 64; o <<= 1) v = fmaxf(v, __shfl_xor(v, o));
    return v;
}
__device__ __forceinline__ float bf2f(unsigned short h) { return __builtin_bit_cast(float, (unsigned)h << 16); }
__device__ __forceinline__ float bflo(unsigned w) { return __builtin_bit_cast(float, w << 16); }
__device__ __forceinline__ float bfhi(unsigned w) { return __builtin_bit_cast(float, w & 0xffff0000u); }

struct P0Item { const float* src; const float* gk; bf16* dst; int N, K; };
__device__ __forceinline__ P0Item p0_decode(int it, unsigned char* ws) {
    constexpr int I_IN = 16 * 176, I_OUT = 44 * 32, I_QKV = 16 * 144, I_OA = 8 * 32, I_UV = 16 * 192, I_OB = 48 * 32;
    const float* W; const float* g = nullptr; bf16* WT; int K, N, mode = 0, r = it, item;
    if (r < 4 * I_IN) { const int i = r / I_IN; item = r % I_IN; W = kin(6) + (size_t)i * DM * NIN; K = DM; N = NIN; g = kin(5) + i * DM; WT = (bf16*)(ws + WS_WIN1 + i * SZ_WIN); mode = 1; }
    else if ((r -= 4 * I_IN) < 4 * I_OUT) { const int i = r / I_OUT; item = r % I_OUT; W = kin(7) + (size_t)i * DFF * DM; K = DFF; N = DM; WT = (bf16*)(ws + WS_WOUT1 + i * SZ_WOUT); }
    else if ((r -= 4 * I_OUT) < 4 * I_IN) { const int i = r / I_IN; item = r % I_IN; W = kin(10) + (size_t)i * DM * NIN; K = DM; N = NIN; g = kin(9) + i * DM; WT = (bf16*)(ws + WS_WIN2 + i * SZ_WIN); mode = 1; }
    else if ((r -= 4 * I_IN) < 4 * I_OUT) { const int i = r / I_OUT; item = r % I_OUT; W = kin(11) + (size_t)i * DFF * DM; K = DFF; N = DM; WT = (bf16*)(ws + WS_WOUT2 + i * SZ_WOUT); }
    else if ((r -= 4 * I_OUT) < 2 * I_QKV) { const int l = r / I_QKV; item = r % I_QKV; W = kin(12) + (size_t)l * DM * QW; K = DM; N = QW; g = kin(8) + (2 * l) * DM; WT = (bf16*)(ws + WS_WQKV + l * SZ_WQKV); }
    else if ((r -= 2 * I_QKV) < 2 * I_OA) { const int l = r / I_OA; item = r % I_OA; W = kin(13) + (size_t)l * AW * DM; K = AW; N = DM; WT = (bf16*)(ws + WS_WOA + l * SZ_WOA); }
    else if ((r -= 2 * I_OA) < 2 * I_UV) { const int l = r / I_UV; item = r % I_UV; W = kin(14) + (size_t)l * DM * UVW; K = DM; N = UVW; g = kin(8) + (2 * l + 1) * DM; WT = (bf16*)(ws + WS_WUV + l * SZ_WUV); }
    else { r -= 2 * I_UV; const int l = r / I_OB; item = r % I_OB; W = kin(19) + (size_t)l * DV * DM; K = DV; N = DM; WT = (bf16*)(ws + WS_WOB + l * SZ_WOB); }
    const int nblk = N / 32, kb = item / nblk, nb = item % nblk, k0 = 64 * kb, n0 = 32 * nb;
    int r0 = n0;
    if (mode == 1) { const int up = n0 >= DFF ? 1 : 0, j = n0 - up * DFF; r0 = 256 * (j >> 7) + 128 * up + (j & 127); }
    P0Item I; I.src = W + (size_t)k0 * N + n0; I.gk = g ? g + k0 : nullptr; I.dst = WT + (size_t)r0 * K + k0; I.N = N; I.K = K; return I;
}
__device__ __forceinline__ void p0_load(const P0Item& I, int lane, f32x4 (&v)[8], f32x4 (&gs)[2]) {
    const int rr = lane >> 3, c4 = lane & 7;
#pragma unroll
    for (int i = 0; i < 8; ++i) v[i] = *(const GAS f32x4*)(I.src + (size_t)(8 * i + rr) * I.N + 4 * c4);
    if (I.gk) { gs[0] = *(const GAS f32x4*)(I.gk + 8 * c4); gs[1] = *(const GAS f32x4*)(I.gk + 8 * c4 + 4); } else { gs[0] = (f32x4){1.f, 1.f, 1.f, 1.f}; gs[1] = gs[0]; }
}
__device__ __forceinline__ void p0_store(const P0Item& I, int lane, const f32x4 (&v)[8], const f32x4 (&gs)[2], LAS float* scr) {
    const int rr = lane >> 3, c4 = lane & 7;
#pragma unroll
    for (int i = 0; i < 8; ++i) { LAS float* d = scr + (8 * i + rr) * 33 + 4 * c4; d[0] = v[i].x; d[1] = v[i].y; d[2] = v[i].z; d[3] = v[i].w; }
    LDS_WAIT(); asm volatile("" ::: "memory");
    const int c = lane & 7;
#pragma unroll
    for (int j = 0; j < 4; ++j) { const int n = (lane >> 3) + 8 * j; const LAS float* s = scr + (8 * c) * 33 + n;
        v4u o; o.x = pk2(gs[0].x * s[0 * 33], gs[0].y * s[1 * 33]); o.y = pk2(gs[0].z * s[2 * 33], gs[0].w * s[3 * 33]); o.z = pk2(gs[1].x * s[4 * 33], gs[1].y * s[5 * 33]); o.w = pk2(gs[1].z * s[6 * 33], gs[1].w * s[7 * 33]);
        *(GAS v4u*)(I.dst + (size_t)n * I.K + 8 * c) = o; }
    LDS_WAIT(); asm volatile("" ::: "memory");
}
constexpr int CV_EVEN = 11008, CV_ODD = 13056, CV_PAIR = CV_EVEN + CV_ODD, CV_TOTAL = 2 * CV_PAIR;
constexpr int CV_PER = 52, CV_PRO = 2816;
__device__ __forceinline__ int cv_layer_end(int L) { return (L >> 1) * CV_PAIR + ((L & 1) ? CV_PAIR : CV_EVEN); }
__device__ __forceinline__ int seq_to_item(int seq) {
    const int pi = seq / CV_PAIR; int r = seq - pi * CV_PAIR; const int odd = r >= CV_EVEN ? 1 : 0; r -= odd * CV_EVEN; const int L = 2 * pi + odd;
    if (r < 2816) return L * 2816 + r; r -= 2816;
    if (r < 1408) return 11264 + L * 1408 + r; r -= 1408;
    if (!odd) { if (r < 2304) return 33792 + pi * 2304 + r; r -= 2304; if (r < 256) return 38400 + pi * 256 + r; r -= 256; }
    else { if (r < 3072) return 38912 + pi * 3072 + r; r -= 3072; if (r < 1536) return 45056 + pi * 1536 + r; r -= 1536; }
    if (r < 2816) return 16896 + L * 2816 + r; r -= 2816;
    return 28160 + L * 1408 + r;
}
__device__ __forceinline__ void convert_range(Frame& F, int seq0, int seq1, int step) {
    LOCAL_IDS;
    LAS float* scr = (LAS float*)(F.lds + RING_OFF + wave * 16384);
    unsigned char* ws = kws();
    for (int sq = seq0; sq < seq1; sq += 2 * step) {
        const bool two = sq + step < seq1;
        const P0Item A = p0_decode(seq_to_item(sq), ws); const P0Item B = p0_decode(seq_to_item(two ? sq + step : sq), ws);
        f32x4 va[8], vb[8]; f32x4 ga[2], gb[2];
        p0_load(A, lane, va, ga); p0_load(B, lane, vb, gb);
        asm volatile("" ::: "memory");
        p0_store(A, lane, va, ga, scr);
        if (two) p0_store(B, lane, vb, gb, scr);
    }
}
__device__ __forceinline__ int convert_slack(Frame& F, int nwg, int base) {
    const int G = F.G, rounds = (nwg + G - 1) / G, c0 = nwg - (rounds - 1) * G, c = (int)blockIdx.x;
    if (c >= c0 && base < CV_TOTAL) { const int wave = __builtin_amdgcn_readfirstlane((int)threadIdx.x >> 6); const int s0 = base + (c - c0) * CV_PER; int s1 = s0 + CV_PER; s1 = s1 < CV_TOTAL ? s1 : CV_TOTAL;
        convert_range(F, s0 + wave, s1, NWAVES); }
    const int nb = base + (G - c0) * CV_PER; return nb < CV_TOTAL ? nb : CV_TOTAL;
}
__device__ __forceinline__ int cv_need(int L, int k) {
    const int start = (L >> 1) * CV_PAIR + ((L & 1) ? CV_EVEN : 0), odd = L & 1;
    const int proj = 4224 + (odd ? 3072 : 2304), outp = proj + (odd ? 1536 : 256);
    const int off = k == 0 ? 2816 : (k == 1 ? 4224 : (k <= 4 ? proj : (k == 5 ? outp : (k == 6 ? outp + 2816 : outp + 4224))));
    return start + off;
}
__device__ __forceinline__ int cv_guard(Frame& F, int base, int need) {
    if (base < need) { __syncthreads();
        const int wave_ = __builtin_amdgcn_readfirstlane((int)threadIdx.x >> 6); convert_range(F, base + F.vcu * NWAVES + wave_, need, F.G * NWAVES); return need; }
    return base;
}
__device__ __forceinline__ void p0_prologue(Frame& F, const Args& a) {
    LOCAL_IDS;
    const int gw = F.vcu * NWAVES + wave, NGW = F.G * NWAVES;
    unsigned char* ws = kws();
    convert_range(F, gw, CV_PRO, NGW);
    { bf16* Wsb = (bf16*)(ws + WS_WSB); for (int e = F.vcu * NTHREADS + tid; e < 2 * 8 * 128 * 128; e += F.G * NTHREADS) { const int t = (e >> 7) & 127, s = e & 127; Wsb[e] = s <= t ? (bf16)f2bf(kin(17)[e]) : (bf16)0; } }
    bf16* XB = (bf16*)(ws + WS_XB); float* SS = (float*)(ws + WS_SS);
    bf16* YZ = (bf16*)(ws + WS_YZ);
    for (int m0 = gw; m0 < MROWS; m0 += 2 * NGW) {
        f32x4 v[2][4];
#pragma unroll
        for (int k = 0; k < 2; ++k) { const int m = m0 + k * NGW; const float* src = m < MP ? kin(0) + (size_t)m * DM : (m < MREAL ? kin(1) + (size_t)(m - MP) * DM : nullptr);
#pragma unroll
            for (int j = 0; j < 4; ++j) v[k][j] = src ? ((const GAS f32x4*)src)[lane + 64 * j] : (f32x4){0.f, 0.f, 0.f, 0.f}; }
        asm volatile("" ::: "memory");
#pragma unroll
        for (int k = 0; k < 2; ++k) { const int m = m0 + k * NGW; if (m < MROWS) { float s = 0.f;
#pragma unroll
            for (int j = 0; j < 4; ++j) { const unsigned w0 = pk2(v[k][j].x, v[k][j].y), w1 = pk2(v[k][j].z, v[k][j].w);
                ((GAS unsigned long long*)(XB + (size_t)m * DM))[lane + 64 * j] = (unsigned long long)w0 | ((unsigned long long)w1 << 32);
                s += (bflo(w0) * bflo(w0) + bfhi(w0) * bfhi(w0)) + (bflo(w1) * bflo(w1) + bfhi(w1) * bfhi(w1)); }
            s = wave_sum(s);
            if (lane < 16) SS[(size_t)m * 16 + lane] = lane == 0 ? s : 0.f;
            if (m >= MP && m < MREAL && lane < 32) ((float*)(ws + WS_SSS))[(size_t)(m - MP) * 32 + lane] = lane == 0 ? s : 0.f;
            if (m >= MREAL) { for (int j = lane; j < DV / 8; j += 64) ((GAS v4u*)(YZ + (size_t)m * DV))[j] = (v4u){0u, 0u, 0u, 0u}; } } }
    }
}

__device__ __forceinline__ float dot64_bf16(const unsigned (&q)[32], const bf16* kp) {
    float s = 0.f;
#pragma unroll
    for (int c = 0; c < 8; ++c) { const v4u kx = *(const GAS v4u*)(kp + 8 * c);
        s += bflo(q[4 * c + 0]) * bflo(kx.x) + bfhi(q[4 * c + 0]) * bfhi(kx.x); s += bflo(q[4 * c + 1]) * bflo(kx.y) + bfhi(q[4 * c + 1]) * bfhi(kx.y);
        s += bflo(q[4 * c + 2]) * bflo(kx.z) + bfhi(q[4 * c + 2]) * bfhi(kx.z); s += bflo(q[4 * c + 3]) * bflo(kx.w) + bfhi(q[4 * c + 3]) * bfhi(kx.w); }
    return s;
}
__device__ __forceinline__ float dot64_f32(const unsigned (&q)[32], const float* kp) {
    float s = 0.f;
#pragma unroll
    for (int c = 0; c < 16; ++c) { const f32x4 kx = *(const GAS f32x4*)(kp + 4 * c);
        s += bflo(q[2 * c]) * kx.x + bfhi(q[2 * c]) * kx.y; s += bflo(q[2 * c + 1]) * kx.z + bfhi(q[2 * c + 1]) * kx.w; }
    return s;
}
__device__ __forceinline__ void load_q(unsigned (&q)[32], const bf16* qp) {
#pragma unroll
    for (int c = 0; c < 8; ++c) { const v4u x = *(const GAS v4u*)(qp + 8 * c); q[4 * c] = x.x; q[4 * c + 1] = x.y; q[4 * c + 2] = x.z; q[4 * c + 3] = x.w; }
}
__device__ __forceinline__ void attn_prompt_v1(Frame& F, const bf16* QKV, bf16* Y) {
    LOCAL_IDS;
    const float NEG = -INFINITY;
    for (int it = F.vcu; it < 256 * 8; it += F.G) {
        const int rb = it >> 3, h = it & 7;
        for (int i = 0; i < 8; ++i) {
            const int r = rb * 64 + wave * 8 + i, t = r & (SEQ - 1);
            float og[3], lse[3];
#pragma unroll
            for (int g = 0; g < 3; ++g) {
                const int sh = 2 * g, m = t >> sh, nk = (m < 128 ? m : 128) + 1;
                const int qcol = g * 512 + h * 64;
                unsigned q[32]; load_q(q, QKV + (size_t)r * QW + qcol);
                const bf16* kb = QKV + (size_t)r * QW + 1536 + qcol; const bf16* vb = QKV + (size_t)r * QW + 3072 + qcol;
                const size_t jstride = (size_t)QW << sh;
                float s0 = NEG, s1 = NEG, s2 = NEG;
                if (lane < nk) s0 = 0.125f * dot64_bf16(q, kb - (size_t)lane * jstride);
                if (lane + 64 < nk) s1 = 0.125f * dot64_bf16(q, kb - (size_t)(lane + 64) * jstride);
                if (nk > 128) { if (lane == 0) s2 = 0.125f * dot64_bf16(q, kb - (size_t)128 * jstride); }
                const float mx = wave_max(fmaxf(fmaxf(s0, s1), s2));
                const float p0 = __expf(s0 - mx), p1 = __expf(s1 - mx), p2 = __expf(s2 - mx);
                const float l = wave_sum(p0 + p1 + p2);
                float o = 0.f;
                const int n0 = nk < 64 ? nk : 64;
                for (int j = 0; j < n0; ++j) o += __shfl(p0, j) * bf2f(vb[lane - (ptrdiff_t)((size_t)j * jstride)]);
                const int n1 = nk - 64 < 64 ? nk - 64 : 64;
                for (int j = 0; j < n1; ++j) o += __shfl(p1, j) * bf2f(vb[lane - (ptrdiff_t)((size_t)(j + 64) * jstride)]);
                if (nk > 128) o += __shfl(p2, 0) * bf2f(vb[lane - (ptrdiff_t)((size_t)128 * jstride)]);
                og[g] = o / l; lse[g] = mx + __logf(l);
            }
            const float M = fmaxf(fmaxf(lse[0], lse[1]), lse[2]);
            const float w0 = __expf(lse[0] - M), w1 = __expf(lse[1] - M), w2 = __expf(lse[2] - M);
            const float y = (w0 * og[0] + w1 * og[1] + w2 * og[2]) / (w0 + w1 + w2);
            Y[(size_t)r * AW + h * 64 + lane] = (bf16)f2bf(y);
        }
    }
}
__device__ __forceinline__ void attn_sample_v1(Frame& F, const Args& a, const bf16* QKV, bf16* Y, int li) {
    LOCAL_IDS;
    const int gw = F.vcu * NWAVES + wave, NGW = F.G * NWAVES;
    for (int task = gw; task < MS * 8; task += NGW) {
        const int sr = task >> 3, h = task & 7, sb = sr >> 2, t = sr & 3, r = MP + sr;
        float og[3], lse[3];
#pragma unroll
        for (int g = 0; g < 3; ++g) {
            const int sh = 2 * g, dil = 1 << sh, L = 128 << sh;
            const float* cache = kin(2 + g) + ((size_t)(li * SB + sb) * L) * 1024;
            const int qcol = g * 512 + h * 64;
            unsigned q[32]; load_q(q, QKV + (size_t)r * QW + qcol);
            float s[3];
#pragma unroll
            for (int rd = 0; rd < 3; ++rd) { const int j = lane + 64 * rd; s[rd] = -INFINITY;
                if (j <= 128) { const int idx = L + t - dil * j;
                    if (idx >= L) s[rd] = 0.125f * dot64_bf16(q, QKV + (size_t)(MP + sb * 4 + (idx - L)) * QW + 1536 + qcol);
                    else s[rd] = 0.125f * dot64_f32(q, cache + (size_t)idx * 1024 + h * 64); } }
            const float mx = wave_max(fmaxf(fmaxf(s[0], s[1]), s[2]));
            const float p0 = __expf(s[0] - mx), p1 = __expf(s[1] - mx), p2 = __expf(s[2] - mx);
            const float l = wave_sum(p0 + p1 + p2);
            float o = 0.f;
            for (int j = 0; j <= 128; ++j) { const float pj = j < 64 ? __shfl(p0, j) : (j < 128 ? __shfl(p1, j - 64) : __shfl(p2, 0));
                const int idx = L + t - dil * j;
                const float v = idx >= L ? bf2f(QKV[(size_t)(MP + sb * 4 + (idx - L)) * QW + 3072 + qcol + lane]) : cache[(size_t)idx * 1024 + 512 + h * 64 + lane];
                o += pj * v; }
            og[g] = o / l; lse[g] = mx + __logf(l);
        }
        const float M = fmaxf(fmaxf(lse[0], lse[1]), lse[2]);
        const float w0 = __expf(lse[0] - M), w1 = __expf(lse[1] - M), w2 = __expf(lse[2] - M);
        const float y = (w0 * og[0] + w1 * og[1] + w2 * og[2]) / (w0 + w1 + w2);
        Y[(size_t)r * AW + h * 64 + lane] = (bf16)f2bf(y);
    }
}

__device__ __forceinline__ void row_stats_bf16(const bf16* vp, int lane, float& mean, float& rstd) {
    float s = 0.f, q = 0.f; v4u xs[6];
#pragma unroll
    for (int j = 0; j < 6; ++j) xs[j] = ((const GAS v4u*)vp)[lane + 64 * j];
    asm volatile("" ::: "memory");
#pragma unroll
    for (int j = 0; j < 6; ++j) { const v4u x = xs[j]; const unsigned w[4] = {x.x, x.y, x.z, x.w};
#pragma unroll
        for (int e = 0; e < 4; ++e) { const float a = bflo(w[e]), b = bfhi(w[e]); s += a + b; q += a * a + b * b; } }
    s = wave_sum(s); q = wave_sum(q);
    mean = s * (1.0f / DV); const float var = q * (1.0f / DV) - mean * mean; rstd = __builtin_amdgcn_rsqf(fmaxf(var, 0.f) + LN_EPS);
}
__device__ __forceinline__ void spatial_prompt_v1(Frame& F, const Args& a, const bf16* UV, bf16* Z, int li) {
    LOCAL_IDS;
    LAS float* Wl = (LAS float*)(F.lds + RING_OFF);
    LAS float* st = (LAS float*)(F.lds + RING_OFF + 65536);
    const float* lng = kin(15) + li * DV; const float* lnb = kin(16) + li * DV;
    for (int it = F.vcu; it < 128 * 8; it += F.G) {
        const int cidx = it >> 3, gg = it & 7, row0 = cidx * 128;
        const float* wsp = kin(17) + (size_t)(li * 8 + gg) * 128 * 128; const float* bsp = kin(18) + (li * 8 + gg) * 128;
        __syncthreads();
        for (int i = 0; i < 16; ++i) { const int rr = wave * 16 + i; float mean, rstd; row_stats_bf16(UV + (size_t)(row0 + rr) * UVW + DV, lane, mean, rstd);
            if (lane == 0) { st[2 * rr] = mean; st[2 * rr + 1] = rstd; } }
        for (int e = tid; e < 128 * 128; e += NTHREADS) { const int t = e >> 7, s = e & 127; Wl[s * 128 + t] = s <= t ? wsp[e] : 0.f; }
        __syncthreads();
        if (tid < 384) {
            const int ch = gg * 384 + tid; const float gain = lng[ch], bias = lnb[ch];
            float acc[128];
#pragma unroll
            for (int t = 0; t < 128; ++t) acc[t] = 0.f;
#pragma unroll 1
            for (int s = 0; s < 128; ++s) {
                const float vn = (bf2f(UV[(size_t)(row0 + s) * UVW + DV + ch]) - st[2 * s]) * st[2 * s + 1] * gain + bias;
#pragma unroll
                for (int t4 = 0; t4 < 32; ++t4) { const f32x4 w = *(const LAS f32x4*)(Wl + s * 128 + 4 * t4);
                    acc[4 * t4] += w.x * vn; acc[4 * t4 + 1] += w.y * vn; acc[4 * t4 + 2] += w.z * vn; acc[4 * t4 + 3] += w.w * vn; }
            }
#pragma unroll
            for (int t = 0; t < 128; ++t) { const float mixed = acc[t] + bsp[t]; const float u = bf2f(UV[(size_t)(row0 + t) * UVW + ch]);
                Z[(size_t)(row0 + t) * DV + ch] = (bf16)f2bf(u * mixed); }
        }
    }
}
__device__ __forceinline__ void spatial_sample_v1(Frame& F, const Args& a, const bf16* UV, bf16* Z, int li) {
    LOCAL_IDS;
    LAS float* st = (LAS float*)(F.lds + RING_OFF + 65536 + 2048);
    const float* lng = kin(15) + li * DV; const float* lnb = kin(16) + li * DV;
    for (int it = F.vcu; it < SB * 6; it += F.G) {
        const int sb = it / 6, cb = it - sb * 6, row0 = MP + sb * 4;
        __syncthreads();
        if (wave < 4) { float mean, rstd; row_stats_bf16(UV + (size_t)(row0 + wave) * UVW + DV, lane, mean, rstd); if (lane == 0) { st[2 * wave] = mean; st[2 * wave + 1] = rstd; } }
        __syncthreads();
        const int ch = cb * NTHREADS + tid, g = ch / 384;
        const float* wsp = kin(17) + (size_t)(li * 8 + g) * 128 * 128; const float* bsp = kin(18) + (li * 8 + g) * 128;
        const float gain = lng[ch], bias = lnb[ch];
        float vr[4], ur[4], bs[4], w[4][4];
#pragma unroll
        for (int t = 0; t < 4; ++t) { vr[t] = bf2f(UV[(size_t)(row0 + t) * UVW + DV + ch]); ur[t] = bf2f(UV[(size_t)(row0 + t) * UVW + ch]); bs[t] = bsp[t];
#pragma unroll
            for (int s = 0; s < 4; ++s) w[t][s] = s <= t ? wsp[t * 128 + s] : 0.f; }
        asm volatile("" ::: "memory");
        float vn[4];
#pragma unroll
        for (int t = 0; t < 4; ++t) { vn[t] = (vr[t] - st[2 * t]) * st[2 * t + 1] * gain + bias;
            kout()[O_VC + ((size_t)(li * SB + sb) * 4 + t) * DV + ch] = vn[t]; }
#pragma unroll
        for (int t = 0; t < 4; ++t) { float mixed = bs[t];
#pragma unroll
            for (int s = 0; s < 4; ++s) mixed += w[t][s] * vn[s];
            Z[(size_t)(row0 + t) * DV + ch] = (bf16)f2bf(ur[t] * mixed); }
    }
}
__device__ __forceinline__ float dpp16_sum(float v) {
    v += __builtin_bit_cast(float, __builtin_amdgcn_update_dpp(0, __builtin_bit_cast(int, v), 0xB1, 0xF, 0xF, false));
    v += __builtin_bit_cast(float, __builtin_amdgcn_update_dpp(0, __builtin_bit_cast(int, v), 0x4E, 0xF, 0xF, false));
    v += __builtin_bit_cast(float, __builtin_amdgcn_update_dpp(0, __builtin_bit_cast(int, v), 0x141, 0xF, 0xF, false));
    v += __builtin_bit_cast(float, __builtin_amdgcn_update_dpp(0, __builtin_bit_cast(int, v), 0x140, 0xF, 0xF, false));
    return v;
}
__device__ __forceinline__ void final_norm(Frame& F, const Args& a) {
    LOCAL_IDS;
    const int gw = F.vcu * NWAVES + wave, NGW = F.G * NWAVES;
    const bf16* XB = (const bf16*)(kws() + WS_XB); const float* SS = (const float*)(kws() + WS_SS); const float* gf = kin(20);
    f32x4 g[4];
#pragma unroll
    for (int j = 0; j < 4; ++j) g[j] = ((const GAS f32x4*)gf)[lane + 64 * j];
    for (int m0 = gw; m0 < MREAL; m0 += 2 * NGW) {
        unsigned long long xw[2][4]; float rs[2];
#pragma unroll
        for (int k = 0; k < 2; ++k) { int m = m0 + k * NGW; m = m < MREAL ? m : MREAL - 1;
            if (m < MP) rs[k] = SS[(size_t)m * 16 + (lane & 15)];     else rs[k] = pg8::any_rstd(SS, (const float*)(kws() + WS_SSS), m);
#pragma unroll
            for (int j = 0; j < 4; ++j) xw[k][j] = ((const GAS unsigned long long*)(XB + (size_t)m * DM))[lane + 64 * j]; }
        asm volatile("" ::: "memory");
#pragma unroll
        for (int k = 0; k < 2; ++k) { const int m = m0 + k * NGW; if (m < MREAL) {
            if (m < MP) rs[k] = __builtin_amdgcn_rsqf(dpp16_sum(rs[k]) * (1.0f / 1024.0f) + 1e-6f);
            float* dst = m < MP ? kout() + O_Y + (size_t)m * DM : kout() + O_YS + (size_t)(m - MP) * DM;
#pragma unroll
            for (int j = 0; j < 4; ++j) { const unsigned w0 = (unsigned)xw[k][j], w1 = (unsigned)(xw[k][j] >> 32);
                ((GAS f32x4*)dst)[lane + 64 * j] = (f32x4){bflo(w0) * rs[k] * g[j].x, bfhi(w0) * rs[k] * g[j].y, bflo(w1) * rs[k] * g[j].z, bfhi(w1) * rs[k] * g[j].w}; } } }
    }
}
typedef float f32x16 __attribute__((ext_vector_type(16)));
typedef short s16x4 __attribute__((ext_vector_type(4)));
typedef short v4i16_t __attribute__((ext_vector_type(4)));
typedef unsigned u32x2 __attribute__((ext_vector_type(2)));
typedef unsigned u32x4 __attribute__((ext_vector_type(4)));
__device__ __forceinline__ unsigned cvtpk(float lo, float hi) { unsigned r; asm volatile("v_cvt_pk_bf16_f32 %0, %1, %2" : "=v"(r) : "v"(lo), "v"(hi)); return r; }
__device__ __forceinline__ s16x4 vtr(const LAS unsigned char* p) { return __builtin_bit_cast(s16x4, __builtin_amdgcn_ds_read_tr16_b64_v4i16((LAS v4i16_t*)p)); }
struct AttnTask { const bf16* base; int m0, sh, r, b, g, kt_lo; };
__device__ __forceinline__ AttnTask attn_task(int u, int h, const bf16* QKV) {
    AttnTask T; const int tq = u & 127, gb = u >> 7; T.g = gb % 3; T.b = gb / 3; T.sh = 2 * T.g;
    const int nq = 128 >> T.sh; T.r = tq >> (7 - T.sh); T.m0 = (tq & (nq - 1)) * 32;
    T.base = QKV + ((size_t)((T.b * 3 + T.g) * 8 + h) * 4096 + (size_t)T.r * (4096 >> T.sh)) * 64;
    T.kt_lo = T.m0 >= 128 ? 0 : 4 - (T.m0 >> 5); return T;
}
__device__ __forceinline__ void attn_load_qk(const AttnTask& T, int jq, int hh, bf16x8 (&qf)[4], bf16x8 (&kf)[5][4]) {
    constexpr size_t SECSTR = (size_t)4 * 3 * 8 * 4096 * 64;
    { const bf16* qp = T.base + (size_t)(T.m0 + jq) * 64 + 32 * hh;
#pragma unroll
      for (int s = 0; s < 4; ++s) qf[s] = *(const GAS bf16x8*)(qp + 8 * s); }
#pragma unroll
    for (int kt = 0; kt < 5; ++kt) { int kpos = T.m0 - 128 + 32 * kt + jq; kpos = kpos < 0 ? 0 : kpos;
        const bf16* kp = T.base + SECSTR + (size_t)kpos * 64 + 32 * hh;
#pragma unroll
        for (int s = 0; s < 4; ++s) kf[kt][s] = *(const GAS bf16x8*)(kp + 8 * s); }
}
__device__ __forceinline__ void attn_load_v(const AttnTask& T, int kt, int lane, v4u (&vx)[4]) {
    constexpr size_t SECSTR = (size_t)4 * 3 * 8 * 4096 * 64;
#pragma unroll
    for (int it = 0; it < 4; ++it) { const int idx = it * 64 + lane, key = idx >> 3, cp = idx & 7; int kpos = T.m0 - 128 + 32 * kt + key; kpos = kpos < 0 ? 0 : kpos;
        vx[it] = *(const GAS v4u*)(T.base + 2 * SECSTR + (size_t)kpos * 64 + cp * 8); }
}
__device__ __forceinline__ void attn_pv_tile(LAS unsigned char* vb, int lane, int trb, const v4u (&vx)[4], const u32x4 (&pw)[2], f32x16& O0, f32x16& O1) {
#pragma unroll
    for (int it = 0; it < 4; ++it) { const int idx = it * 64 + lane, key = idx >> 3, cp = idx & 7;
        *(LAS v4u*)(vb + (cp >> 2) * 2048 + key * 64 + (cp & 3) * 16) = vx[it]; }
#pragma unroll
    for (int sp = 0; sp < 2; ++sp) { const bf16x8 pf = __builtin_bit_cast(bf16x8, pw[sp]);
        { const s16x4 lo = vtr(vb + sp * 1024 + trb), hi = vtr(vb + sp * 1024 + 512 + trb);
          const bf16x8 vf = (bf16x8){lo[0], lo[1], lo[2], lo[3], hi[0], hi[1], hi[2], hi[3]};
          O0 = __builtin_amdgcn_mfma_f32_32x32x16_bf16(vf, pf, O0, 0, 0, 0); }
        { const s16x4 lo = vtr(vb + 2048 + sp * 1024 + trb), hi = vtr(vb + 2048 + sp * 1024 + 512 + trb);
          const bf16x8 vf = (bf16x8){lo[0], lo[1], lo[2], lo[3], hi[0], hi[1], hi[2], hi[3]};
          O1 = __builtin_amdgcn_mfma_f32_32x32x16_bf16(vf, pf, O1, 0, 0, 0); } }
}
__device__ __forceinline__ void attn_prompt_mfma(Frame& F, const bf16* QKV, bf16* OG, float* LSE) {
    LOCAL_IDS;
    const int jq = lane & 31, hh = lane >> 5, h = wave;
    LAS unsigned char* vst = F.lds + RING_OFF + wave * 8192;
    const int trb = ((lane >> 4) & 1) * 32 + (lane & 3) * 8 + (4 * hh + ((lane & 15) >> 2)) * 64;
    const float NEG = -INFINITY, c = 0.125f * 1.4426950408889634f;
    int u = F.vcu;
    if (u >= 1536) return;
    AttnTask T = attn_task(u, h, QKV);
    bf16x8 qf[4], kf[5][4];
    attn_load_qk(T, jq, hh, qf, kf);
    for (;;) {
        f32x16 S[5];
#pragma unroll
        for (int kt = 0; kt < 5; ++kt) {
#pragma unroll
            for (int e = 0; e < 16; ++e) S[kt][e] = 0.f;
#pragma unroll
            for (int s = 0; s < 4; ++s) S[kt] = __builtin_amdgcn_mfma_f32_32x32x16_bf16(kf[kt][s], qf[s], S[kt], 0, 0, 0);
        }
        v4u va[4], vb4[4];
        attn_load_v(T, 0, lane, va); attn_load_v(T, 1, lane, vb4);
#pragma unroll
        for (int e = 0; e < 16; ++e) { const int i = (e & 3) + 8 * (e >> 2) + 4 * hh; if (i < jq) S[0][e] = NEG; if (i > jq) S[4][e] = NEG; }
#pragma unroll
        for (int kt = 0; kt < 4; ++kt) { const bool dead = kt < T.kt_lo;
#pragma unroll
            for (int e = 0; e < 16; ++e) S[kt][e] = dead ? NEG : S[kt][e]; }
        float mx = NEG;
#pragma unroll
        for (int kt = 0; kt < 5; ++kt)
#pragma unroll
            for (int e = 0; e < 16; ++e) mx = fmaxf(mx, S[kt][e]);
        mx = fmaxf(mx, __shfl_xor(mx, 32));
        float l = 0.f; u32x4 pw[5][2]; const float nmc = -mx * c;
#pragma unroll
        for (int kt = 0; kt < 5; ++kt) {
#pragma unroll
            for (int e = 0; e < 16; ++e) { const float pv = __builtin_amdgcn_exp2f(__builtin_fmaf(S[kt][e], c, nmc)); S[kt][e] = pv; l += pv; }
#pragma unroll
            for (int sp = 0; sp < 2; ++sp) { pw[kt][sp].x = cvtpk(S[kt][8 * sp + 0], S[kt][8 * sp + 1]); pw[kt][sp].y = cvtpk(S[kt][8 * sp + 2], S[kt][8 * sp + 3]); pw[kt][sp].z = cvtpk(S[kt][8 * sp + 4], S[kt][8 * sp + 5]); pw[kt][sp].w = cvtpk(S[kt][8 * sp + 6], S[kt][8 * sp + 7]); } }
        l += __shfl_xor(l, 32);
        const int un = u + F.G; const bool more = un < 1536;
        const AttnTask Tc = T;
        if (more) { T = attn_task(un, h, QKV); attn_load_qk(T, jq, hh, qf, kf); }
        f32x16 O0, O1;
#pragma unroll
        for (int e = 0; e < 16; ++e) { O0[e] = 0.f; O1[e] = 0.f; }
        attn_pv_tile(vst, lane, trb, va, pw[0], O0, O1);          attn_load_v(Tc, 2, lane, va);
        attn_pv_tile(vst + 4096, lane, trb, vb4, pw[1], O0, O1);  attn_load_v(Tc, 3, lane, vb4);
        attn_pv_tile(vst, lane, trb, va, pw[2], O0, O1);          attn_load_v(Tc, 4, lane, va);
        attn_pv_tile(vst + 4096, lane, trb, vb4, pw[3], O0, O1);
        attn_pv_tile(vst, lane, trb, va, pw[4], O0, O1);
        const float inv = 1.0f / l;
        const int row = Tc.b * SEQ + ((Tc.m0 + jq) << Tc.sh) + Tc.r;
        bf16* op = OG + ((size_t)Tc.g * MREAL + row) * AW + h * 64 + 4 * hh;
#pragma unroll
        for (int a4 = 0; a4 < 4; ++a4) {
            u32x2 w0; w0.x = cvtpk(O0[4 * a4] * inv, O0[4 * a4 + 1] * inv); w0.y = cvtpk(O0[4 * a4 + 2] * inv, O0[4 * a4 + 3] * inv); *(GAS u32x2*)(op + 8 * a4) = w0;
            u32x2 w1; w1.x = cvtpk(O1[4 * a4] * inv, O1[4 * a4 + 1] * inv); w1.y = cvtpk(O1[4 * a4 + 2] * inv, O1[4 * a4 + 3] * inv); *(GAS u32x2*)(op + 32 + 8 * a4) = w1; }
        if (hh == 0) LSE[((size_t)Tc.g * MREAL + row) * 8 + h] = mx * 0.125f + __logf(l);
        if (!more) break;
        u = un;
    }
}
__device__ __forceinline__ void attn_merge(Frame& F, const bf16* OG, const bf16* OGS, const float* LSE, bf16* Y) {
    LOCAL_IDS;
    constexpr int NIT = MREAL * 64, UNR = 4;
    const int stride = F.G * NTHREADS;
    for (int base = F.vcu * NTHREADS + tid; base < NIT; base += UNR * stride) {
        v4u x0[UNR], x1[UNR], x2[UNR]; float l0[UNR], l1[UNR], l2[UNR];
#pragma unroll
        for (int k = 0; k < UNR; ++k) { int idx = base + k * stride; idx = idx < NIT ? idx : NIT - 1; const int row = idx >> 6, c8 = idx & 63, h = c8 >> 3, pc = c8 & 7;
            { const f32x4 lv = *(const GAS f32x4*)(LSE + ((size_t)row * 8 + h) * 4); l0[k] = lv.x; l1[k] = lv.y; l2[k] = lv.z; }
            const bf16 *p0, *p1, *p2;
            if (row < MP) { const int b = row >> 12, t = row & 4095;
                p0 = OG + ((size_t)((0 * 4 + b) * 8 + h) * 4096 + t) * 64 + pc * 8;
                p1 = OG + ((size_t)((1 * 4 + b) * 8 + h) * 4096 + ((t & 3) << 10) + (t >> 2)) * 64 + pc * 8;
                p2 = OG + ((size_t)((2 * 4 + b) * 8 + h) * 4096 + ((t & 15) << 8) + (t >> 4)) * 64 + pc * 8;
            } else { const int sr = row - MP; p0 = OGS + (size_t)sr * AW + c8 * 8; p1 = OGS + ((size_t)MS + sr) * AW + c8 * 8; p2 = OGS + ((size_t)2 * MS + sr) * AW + c8 * 8; }
            x0[k] = *(const GAS v4u*)p0; x1[k] = *(const GAS v4u*)p1; x2[k] = *(const GAS v4u*)p2; }
        asm volatile("" ::: "memory");
#pragma unroll
        for (int k = 0; k < UNR; ++k) { const int idx = base + k * stride; if (idx < NIT) { const int row = idx >> 6, c8 = idx & 63;
            const float M = fmaxf(fmaxf(l0[k], l1[k]), l2[k]);
            float w0 = __expf(l0[k] - M), w1 = __expf(l1[k] - M), w2 = __expf(l2[k] - M); const float inv = 1.0f / (w0 + w1 + w2); w0 *= inv; w1 *= inv; w2 *= inv;
            const unsigned a0[4] = {x0[k].x, x0[k].y, x0[k].z, x0[k].w}, a1[4] = {x1[k].x, x1[k].y, x1[k].z, x1[k].w}, a2[4] = {x2[k].x, x2[k].y, x2[k].z, x2[k].w}; unsigned o[4];
#pragma unroll
            for (int e = 0; e < 4; ++e) o[e] = pk2(w0 * bflo(a0[e]) + w1 * bflo(a1[e]) + w2 * bflo(a2[e]), w0 * bfhi(a0[e]) + w1 * bfhi(a1[e]) + w2 * bfhi(a2[e]));
            *(GAS v4u*)(Y + (size_t)row * AW + c8 * 8) = (v4u){o[0], o[1], o[2], o[3]}; } }
    }
}
__device__ __forceinline__ void attn_core(const AttnTask& T, int jq, int hh, int lane, LAS unsigned char* vst, int trb, f32x16& O0, f32x16& O1, float& l, float& mx) {
    const float NEG = -INFINITY, c = 0.125f * 1.4426950408889634f;
    bf16x8 qf[4], kf[5][4];
    attn_load_qk(T, jq, hh, qf, kf);
    f32x16 S[5];
#pragma unroll
    for (int kt = 0; kt < 5; ++kt) {
#pragma unroll
        for (int e = 0; e < 16; ++e) S[kt][e] = 0.f;
#pragma unroll
        for (int s = 0; s < 4; ++s) S[kt] = __builtin_amdgcn_mfma_f32_32x32x16_bf16(kf[kt][s], qf[s], S[kt], 0, 0, 0);
    }
    v4u va[4], vb4[4];
    attn_load_v(T, 0, lane, va); attn_load_v(T, 1, lane, vb4);
#pragma unroll
    for (int e = 0; e < 16; ++e) { const int i = (e & 3) + 8 * (e >> 2) + 4 * hh; if (i < jq) S[0][e] = NEG; if (i > jq) S[4][e] = NEG; }
#pragma unroll
    for (int kt = 0; kt < 4; ++kt) { const bool dead = kt < T.kt_lo;
#pragma unroll
        for (int e = 0; e < 16; ++e) S[kt][e] = dead ? NEG : S[kt][e]; }
    mx = NEG;
#pragma unroll
    for (int kt = 0; kt < 5; ++kt)
#pragma unroll
        for (int e = 0; e < 16; ++e) mx = fmaxf(mx, S[kt][e]);
    mx = fmaxf(mx, __shfl_xor(mx, 32));
    l = 0.f; u32x4 pw[5][2];
#pragma unroll
    for (int kt = 0; kt < 5; ++kt) {
#pragma unroll
        for (int e = 0; e < 16; ++e) { const float pv = __builtin_amdgcn_exp2f((S[kt][e] - mx) * c); S[kt][e] = pv; l += pv; }
#pragma unroll
        for (int sp = 0; sp < 2; ++sp) { pw[kt][sp].x = cvtpk(S[kt][8 * sp + 0], S[kt][8 * sp + 1]); pw[kt][sp].y = cvtpk(S[kt][8 * sp + 2], S[kt][8 * sp + 3]); pw[kt][sp].z = cvtpk(S[kt][8 * sp + 4], S[kt][8 * sp + 5]); pw[kt][sp].w = cvtpk(S[kt][8 * sp + 6], S[kt][8 * sp + 7]); } }
    l += __shfl_xor(l, 32);
#pragma unroll
    for (int e = 0; e < 16; ++e) { O0[e] = 0.f; O1[e] = 0.f; }
    attn_pv_tile(vst, lane, trb, va, pw[0], O0, O1);          attn_load_v(T, 2, lane, va);
    attn_pv_tile(vst + 4096, lane, trb, vb4, pw[1], O0, O1);  attn_load_v(T, 3, lane, vb4);
    attn_pv_tile(vst, lane, trb, va, pw[2], O0, O1);          attn_load_v(T, 4, lane, va);
    attn_pv_tile(vst + 4096, lane, trb, vb4, pw[3], O0, O1);
    attn_pv_tile(vst, lane, trb, va, pw[4], O0, O1);
}
constexpr int AF_ROWB = 136, AF_LSE = 512 * AF_ROWB, AF_VST = AF_LSE + 2048;
__device__ __forceinline__ void attn_fused(Frame& F, const bf16* QKV, bf16* Y) {
    LOCAL_IDS;
    const int jq = lane & 31, hh = lane >> 5;
    LAS unsigned char* tab = F.lds + RING_OFF; LAS float* lseL = (LAS float*)(F.lds + RING_OFF + AF_LSE);
    LAS unsigned char* vst = F.lds + RING_OFF + AF_VST + wave * 8192;
    const int trb = ((lane >> 4) & 1) * 32 + (lane & 3) * 8 + (4 * hh + ((lane & 15) >> 2)) * 64;
    for (int u = F.vcu; u < 256; u += F.G) {
        const int blk = u & 7, h = (u >> 3) & 7, b = u >> 6;
#pragma unroll
        for (int g = 0; g < 3; ++g) {
            const int sh = 2 * g;
            for (int qi = 0; qi < 2; ++qi) {
                const int q16 = 2 * wave + qi;
                AttnTask T; T.g = g; T.b = b; T.sh = sh;
                T.r = g == 0 ? 0 : (g == 1 ? (q16 >> 2) : q16);
                T.m0 = g == 0 ? 512 * blk + 32 * q16 : (g == 1 ? 128 * blk + 32 * (q16 & 3) : 32 * blk);
                T.base = QKV + ((size_t)((b * 3 + g) * 8 + h) * 4096 + (size_t)T.r * (4096 >> sh)) * 64;
                T.kt_lo = T.m0 >= 128 ? 0 : 4 - (T.m0 >> 5);
                f32x16 O0, O1; float l, mx;
                attn_core(T, jq, hh, lane, vst, trb, O0, O1, l, mx);
                const float inv = 1.0f / l; float lse = mx * 0.125f + __logf(l);
                const int pos = ((T.m0 + jq) << sh) + T.r - 512 * blk;
                LAS unsigned char* trow = tab + pos * AF_ROWB + 8 * hh;
                float wa = 0.f, wb = 1.0f;
                if (g > 0) { const float la = lseL[pos], M = fmaxf(la, lse); const float ea = __expf(la - M), eb = __expf(lse - M), rs = 1.0f / (ea + eb); wa = ea * rs; wb = eb * rs; lse = M + __logf(ea + eb); }
                wb *= inv;
#pragma unroll
                for (int a4 = 0; a4 < 4; ++a4) {
                    float o0[4], o1[4];
#pragma unroll
                    for (int e = 0; e < 4; ++e) { o0[e] = O0[4 * a4 + e] * wb; o1[e] = O1[4 * a4 + e] * wb; }
                    if (g > 0) { const u32x2 p0 = *(const LAS u32x2*)(trow + 16 * a4), p1 = *(const LAS u32x2*)(trow + 64 + 16 * a4);
                        o0[0] += wa * bflo(p0.x); o0[1] += wa * bfhi(p0.x); o0[2] += wa * bflo(p0.y); o0[3] += wa * bfhi(p0.y);
                        o1[0] += wa * bflo(p1.x); o1[1] += wa * bfhi(p1.x); o1[2] += wa * bflo(p1.y); o1[3] += wa * bfhi(p1.y); }
                    u32x2 w0; w0.x = cvtpk(o0[0], o0[1]); w0.y = cvtpk(o0[2], o0[3]); *(LAS u32x2*)(trow + 16 * a4) = w0;
                    u32x2 w1; w1.x = cvtpk(o1[0], o1[1]); w1.y = cvtpk(o1[2], o1[3]); *(LAS u32x2*)(trow + 64 + 16 * a4) = w1; }
                if (hh == 0) lseL[pos] = lse;
            }
            __syncthreads();
        }
#pragma unroll
        for (int k = 0; k < 8; ++k) { const int pc = tid + NTHREADS * k, pos = pc >> 3, c8 = pc & 7;
            const u32x2 x0 = *(const LAS u32x2*)(tab + pos * AF_ROWB + c8 * 16), x1 = *(const LAS u32x2*)(tab + pos * AF_ROWB + c8 * 16 + 8);
            *(GAS v4u*)(Y + ((size_t)(b * SEQ + 512 * blk + pos)) * AW + h * 64 + c8 * 8) = (v4u){x0.x, x0.y, x1.x, x1.y}; }
        __syncthreads();
    }
}

__device__ __forceinline__ void attn_prompt_shared(Frame& F, const bf16* QKV, bf16* OG, float* LSE) {
    LOCAL_IDS;
    const int jq = lane & 31, hh = lane >> 5;
    LAS unsigned char* kimg = F.lds + RING_OFF;
    LAS unsigned char* vimg = F.lds + RING_OFF + 49152;
    const int trb = ((lane >> 4) & 1) * 32 + (lane & 3) * 8 + (4 * hh + ((lane & 15) >> 2)) * 64;
    constexpr size_t SECSTR = (size_t)4 * 3 * 8 * 4096 * 64;
    const float NEG = -INFINITY, c = 0.125f * 1.4426950408889634f;
    int u = F.vcu;
    if (u >= 1536) return;
    v4u kx[6], vx[6]; bf16x8 qf[4];
#define AS_DECODE(U, BASE, M0, SH, R, B_, G_, H_) \
    const int uq_ = (U) & 15, bgh_ = (U) >> 4; const int H_ = bgh_ & 7, G_ = (bgh_ >> 3) % 3, B_ = (bgh_ >> 3) / 3, SH = 2 * G_; \
    const int R = uq_ >> (4 - SH), M0 = 256 * (uq_ & ((16 >> SH) - 1)); \
    const bf16* BASE = QKV + ((size_t)((B_ * 3 + G_) * 8 + H_) * 4096 + (size_t)R * (4096 >> SH)) * 64;
#define AS_LOAD(BASE, M0) { _Pragma("unroll") for (int n = 0; n < 6; ++n) { const int idx = wave + 8 * n; \
        { const int tile = idx >> 2, chunk = 2 * (idx & 3) + (lane >> 5); int kpos = (M0) - 128 + tile * 32 + (lane & 31); kpos = kpos < 0 ? 0 : kpos; \
          kx[n] = *(const GAS v4u*)((BASE) + SECSTR + (size_t)kpos * 64 + chunk * 8); } \
        { const int tile = idx >> 2, dh = (idx >> 1) & 1, key = (lane >> 2) + 16 * (idx & 1); int kpos = (M0) - 128 + tile * 32 + key; kpos = kpos < 0 ? 0 : kpos; \
          vx[n] = *(const GAS v4u*)((BASE) + 2 * SECSTR + (size_t)kpos * 64 + dh * 32 + (lane & 3) * 8); } } \
        { const bf16* qp_ = (BASE) + (size_t)((M0) + 32 * wave + jq) * 64 + 32 * hh; _Pragma("unroll") for (int s = 0; s < 4; ++s) qn[s] = *(const GAS bf16x8*)(qp_ + 8 * s); } }
    bf16x8 qn[4];
    { AS_DECODE(u, base0, m00, sh0, r0, b0, g0, h0) (void)sh0; (void)r0; (void)b0; (void)g0; (void)h0; AS_LOAD(base0, m00) }
    for (;;) {
        AS_DECODE(u, base, m0, sh, r, b, g, h)
        __syncthreads();
#pragma unroll
        for (int n = 0; n < 6; ++n) { const int idx = wave + 8 * n;
            *(LAS v4u*)(kimg + (idx >> 2) * 4096 + (2 * (idx & 3) + (lane >> 5)) * 512 + (lane & 31) * 16) = kx[n];
            *(LAS v4u*)(vimg + (idx >> 2) * 4096 + ((idx >> 1) & 1) * 2048 + ((lane >> 2) + 16 * (idx & 1)) * 64 + (lane & 3) * 16) = vx[n]; }
        __syncthreads();
#pragma unroll
        for (int s = 0; s < 4; ++s) qf[s] = qn[s];
        const int un = u + F.G; const bool more = un < 1536;
        if (more) { AS_DECODE(un, basen, m0n, shn, rn, bn, gn, hn) (void)shn; (void)rn; (void)bn; (void)gn; (void)hn; AS_LOAD(basen, m0n) }
        const int mq = m0 + 32 * wave; const int kt_lo = mq >= 128 ? 0 : 4 - (mq >> 5);
        f32x16 S[5];
#pragma unroll
        for (int kt = 0; kt < 5; ++kt) {
            const float z0 = (kt < 4 && kt < kt_lo) ? NEG : 0.f;
#pragma unroll
            for (int e = 0; e < 16; ++e) S[kt][e] = z0;
            const LAS unsigned char* kb = kimg + (wave + kt) * 4096 + (4 * hh) * 512 + jq * 16;
#pragma unroll
            for (int s = 0; s < 4; ++s) { const bf16x8 kf = *(const LAS bf16x8*)(kb + s * 512); S[kt] = __builtin_amdgcn_mfma_f32_32x32x16_bf16(kf, qf[s], S[kt], 0, 0, 0); }
        }
#pragma unroll
        for (int e = 0; e < 16; ++e) { const int i = (e & 3) + 8 * (e >> 2) + 4 * hh; if (i < jq) S[0][e] = NEG; if (i > jq) S[4][e] = NEG; }
        float mx = NEG;
#pragma unroll
        for (int kt = 0; kt < 5; ++kt)
#pragma unroll
            for (int e = 0; e < 16; ++e) mx = fmaxf(mx, S[kt][e]);
        mx = fmaxf(mx, __shfl_xor(mx, 32));
        float l = 0.f; u32x4 pw[5][2]; const float nmc = -mx * c;
#pragma unroll
        for (int kt = 0; kt < 5; ++kt) {
#pragma unroll
            for (int e = 0; e < 16; ++e) { const float pv = __builtin_amdgcn_exp2f(__builtin_fmaf(S[kt][e], c, nmc)); S[kt][e] = pv; l += pv; }
#pragma unroll
            for (int sp = 0; sp < 2; ++sp) { pw[kt][sp].x = cvtpk(S[kt][8 * sp + 0], S[kt][8 * sp + 1]); pw[kt][sp].y = cvtpk(S[kt][8 * sp + 2], S[kt][8 * sp + 3]); pw[kt][sp].z = cvtpk(S[kt][8 * sp + 4], S[kt][8 * sp + 5]); pw[kt][sp].w = cvtpk(S[kt][8 * sp + 6], S[kt][8 * sp + 7]); } }
        l += __shfl_xor(l, 32);
        f32x16 O0, O1;
#pragma unroll
        for (int e = 0; e < 16; ++e) { O0[e] = 0.f; O1[e] = 0.f; }
#pragma unroll
        for (int kt = 0; kt < 5; ++kt) { const LAS unsigned char* vb = vimg + (wave + kt) * 4096;
#pragma unroll
            for (int sp = 0; sp < 2; ++sp) { const bf16x8 pf = __builtin_bit_cast(bf16x8, pw[kt][sp]);
                { const s16x4 lo = vtr(vb + sp * 1024 + trb), hi = vtr(vb + sp * 1024 + 512 + trb);
                  const bf16x8 vf = (bf16x8){lo[0], lo[1], lo[2], lo[3], hi[0], hi[1], hi[2], hi[3]};
                  O0 = __builtin_amdgcn_mfma_f32_32x32x16_bf16(vf, pf, O0, 0, 0, 0); }
                { const s16x4 lo = vtr(vb + 2048 + sp * 1024 + trb), hi = vtr(vb + 2048 + sp * 1024 + 512 + trb);
                  const bf16x8 vf = (bf16x8){lo[0], lo[1], lo[2], lo[3], hi[0], hi[1], hi[2], hi[3]};
                  O1 = __builtin_amdgcn_mfma_f32_32x32x16_bf16(vf, pf, O1, 0, 0, 0); } } }
        const float inv = 1.0f / l;
        const int row = b * SEQ + ((mq + jq) << sh) + r;
        { LAS unsigned char* stg = F.lds + RING_OFF + 98304 + wave * 4352;
          LAS unsigned char* srow = stg + jq * 136 + 8 * hh;
#pragma unroll
          for (int a4 = 0; a4 < 4; ++a4) {
              u32x2 w0; w0.x = cvtpk(O0[4 * a4] * inv, O0[4 * a4 + 1] * inv); w0.y = cvtpk(O0[4 * a4 + 2] * inv, O0[4 * a4 + 3] * inv); *(LAS u32x2*)(srow + 16 * a4) = w0;
              u32x2 w1; w1.x = cvtpk(O1[4 * a4] * inv, O1[4 * a4 + 1] * inv); w1.y = cvtpk(O1[4 * a4 + 2] * inv, O1[4 * a4 + 3] * inv); *(LAS u32x2*)(srow + 64 + 16 * a4) = w1; }
          bf16* ob = OG + ((size_t)((g * 4 + b) * 8 + h) * 4096 + (size_t)r * (4096 >> sh) + mq) * 64;
#pragma unroll
          for (int it = 0; it < 4; ++it) { const int q = it * 8 + (lane >> 3), pc = lane & 7;
              const u32x2 x0 = *(const LAS u32x2*)(stg + q * 136 + pc * 16), x1 = *(const LAS u32x2*)(stg + q * 136 + pc * 16 + 8);
              *(GAS v4u*)(ob + q * 64 + pc * 8) = (v4u){x0.x, x0.y, x1.x, x1.y}; } }
        if (hh == 0) LSE[((size_t)row * 8 + h) * 4 + g] = mx * 0.125f + __logf(l);
        if (!more) break;
        u = un;
    }
#undef AS_DECODE
#undef AS_LOAD
}
__device__ __forceinline__ f32x4 ld_new4(const bf16* p) { const u32x2 w = *(const GAS u32x2*)p; return (f32x4){bflo(w.x), bfhi(w.x), bflo(w.y), bfhi(w.y)}; }
__device__ __forceinline__ float row16_sum(float v) {
    v += __builtin_bit_cast(float, __builtin_amdgcn_update_dpp(0, __builtin_bit_cast(int, v), 0xB1, 0xF, 0xF, false));
    v += __builtin_bit_cast(float, __builtin_amdgcn_update_dpp(0, __builtin_bit_cast(int, v), 0x4E, 0xF, 0xF, false));
    v += __builtin_bit_cast(float, __builtin_amdgcn_update_dpp(0, __builtin_bit_cast(int, v), 0x141, 0xF, 0xF, false));
    v += __builtin_bit_cast(float, __builtin_amdgcn_update_dpp(0, __builtin_bit_cast(int, v), 0x140, 0xF, 0xF, false));
    return v;
}
__device__ __forceinline__ void attn_sample_v2(Frame& F, const Args& a, const bf16* QKV, bf16* OG, float* LSE, int li) {
    LOCAL_IDS;
    const int kk = lane >> 4, dp = lane & 15;
    const int gw = F.vcu * NWAVES + wave, NGW = F.G * NWAVES;
    for (int task = gw; task < MS * 24; task += NGW) {
        const int h = task & 7, g = (task >> 3) % 3, sr = task / 24, sb = sr >> 2, t = sr & 3, r = MP + sr;
        const int sh = 2 * g, dil = 1 << sh, L = 128 << sh;
        const float* cache = kin(2 + g) + ((size_t)(li * SB + sb) * L) * 1024 + h * 64 + 4 * dp;
        const float* newkv = kout() + (g == 0 ? O_KV128S : (g == 1 ? O_KV512S : O_KV2048S)) + ((size_t)(li * SB + sb) * 4) * 1024 + h * 64 + 4 * dp;
        const f32x4 q4 = ld_new4(QKV + (size_t)r * QW + g * 512 + h * 64 + 4 * dp);
        float sa[11], sb_[11], sc_[11];
#define SK_BATCH(BT, SARR) { f32x4 kv[11]; \
            _Pragma("unroll") for (int i = 0; i < 11; ++i) { const int it = 11 * (BT) + i, j0 = 4 * it + kk, j = j0 > 128 ? 128 : j0, idx = L + t - dil * j; \
                const float* rp = idx >= L ? newkv + (size_t)(idx - L) * 1024 : cache + (size_t)idx * 1024; kv[i] = *(const GAS f32x4*)rp; } \
            _Pragma("unroll") for (int i = 0; i < 11; ++i) { const int it = 11 * (BT) + i, j0 = 4 * it + kk; \
                const float s = row16_sum((q4.x * kv[i].x + q4.y * kv[i].y) + (q4.z * kv[i].z + q4.w * kv[i].w)); \
                SARR[i] = j0 <= 128 ? 0.125f * s : -INFINITY; } }
        SK_BATCH(0, sa) SK_BATCH(1, sb_) SK_BATCH(2, sc_)
#undef SK_BATCH
        float mx = sa[0];
#pragma unroll
        for (int i = 0; i < 11; ++i) mx = fmaxf(fmaxf(mx, sa[i]), fmaxf(sb_[i], sc_[i]));
        mx = fmaxf(mx, __shfl_xor(mx, 16)); mx = fmaxf(mx, __shfl_xor(mx, 32));
        float l = 0.f;
#pragma unroll
        for (int i = 0; i < 11; ++i) { sa[i] = __expf(sa[i] - mx); sb_[i] = __expf(sb_[i] - mx); sc_[i] = __expf(sc_[i] - mx); l += (sa[i] + sb_[i]) + sc_[i]; }
        l += __shfl_xor(l, 16); l += __shfl_xor(l, 32);
        f32x4 o = (f32x4){0.f, 0.f, 0.f, 0.f};
#define SV_BATCH(BT, SARR) { f32x4 vv[11]; \
            _Pragma("unroll") for (int i = 0; i < 11; ++i) { const int it = 11 * (BT) + i, j0 = 4 * it + kk, j = j0 > 128 ? 128 : j0, idx = L + t - dil * j; \
                const float* rp = idx >= L ? newkv + (size_t)(idx - L) * 1024 : cache + (size_t)idx * 1024; vv[i] = *(const GAS f32x4*)(rp + 512); } \
            _Pragma("unroll") for (int i = 0; i < 11; ++i) o = o + vv[i] * SARR[i]; }
        SV_BATCH(0, sa) SV_BATCH(1, sb_) SV_BATCH(2, sc_)
#undef SV_BATCH
#pragma unroll
        for (int e = 0; e < 4; ++e) { o[e] += __shfl_xor(o[e], 16); o[e] += __shfl_xor(o[e], 32); }
        const float inv = 1.0f / l;
        if (kk == 0) { u32x2 w; w.x = cvtpk(o[0] * inv, o[1] * inv); w.y = cvtpk(o[2] * inv, o[3] * inv); *(GAS u32x2*)(OG + ((size_t)g * MS + sr) * AW + h * 64 + 4 * dp) = w; }
        if (lane == 0) LSE[((size_t)r * 8 + h) * 4 + g] = mx + __logf(l);
    }
}

__device__ __forceinline__ void attn_sample_v3(Frame& F, const Args& a, const bf16* QKV, bf16* Y, int li) {
    LOCAL_IDS;
    const int kk = lane >> 4, dp = lane & 15;
    const int gw = F.vcu * NWAVES + wave, NGW = F.G * NWAVES;
    for (int task = gw; task < MS * 8; task += NGW) {
        const int h = task & 7, sr = task >> 3, sb = sr >> 2, t = sr & 3, r = MP + sr;
        f32x4 og[3]; float lg[3];
#pragma unroll
        for (int g = 0; g < 3; ++g) {
        const int sh = 2 * g, dil = 1 << sh, L = 128 << sh;
        const float* cache = kin(2 + g) + ((size_t)(li * SB + sb) * L) * 1024 + h * 64 + 4 * dp;
        const bf16* qn = QKV + (size_t)(MP + sb * 4) * QW + g * 512 + h * 64 + 4 * dp;
        const f32x4 q4 = ld_new4(QKV + (size_t)r * QW + g * 512 + h * 64 + 4 * dp);
        float sc[33];
#pragma unroll
        for (int it = 0; it < 33; ++it) { const int j = 4 * it + kk, idx = L + t - dil * j; float s = 0.f;
            if (j <= 128) { const f32x4 kv = idx >= L ? ld_new4(qn + (size_t)(idx - L) * QW + 1536) : *(const GAS f32x4*)(cache + (size_t)idx * 1024);
                s = (q4.x * kv.x + q4.y * kv.y) + (q4.z * kv.z + q4.w * kv.w); }
            s += __shfl_xor(s, 1); s += __shfl_xor(s, 2); s += __shfl_xor(s, 4); s += __shfl_xor(s, 8);
            sc[it] = j <= 128 ? 0.125f * s : -INFINITY;
            if ((it & 7) == 7) asm volatile("" ::: "memory"); }
        float mx = sc[0];
#pragma unroll
        for (int it = 1; it < 33; ++it) mx = fmaxf(mx, sc[it]);
        mx = fmaxf(mx, __shfl_xor(mx, 16)); mx = fmaxf(mx, __shfl_xor(mx, 32));
        float l = 0.f;
#pragma unroll
        for (int it = 0; it < 33; ++it) { sc[it] = __expf(sc[it] - mx); l += sc[it]; }
        l += __shfl_xor(l, 16); l += __shfl_xor(l, 32);
        f32x4 o = (f32x4){0.f, 0.f, 0.f, 0.f};
#pragma unroll
        for (int it = 0; it < 33; ++it) { const int j = 4 * it + kk, idx = L + t - dil * j;
            if (j <= 128) { const f32x4 vv = idx >= L ? ld_new4(qn + (size_t)(idx - L) * QW + 3072) : *(const GAS f32x4*)(cache + (size_t)idx * 1024 + 512);
                o = o + vv * sc[it]; }
            if ((it & 7) == 7) asm volatile("" ::: "memory"); }
#pragma unroll
        for (int e = 0; e < 4; ++e) { o[e] += __shfl_xor(o[e], 16); o[e] += __shfl_xor(o[e], 32); }
        og[g] = o * (1.0f / l); lg[g] = mx + __logf(l);
        }
        const float M = fmaxf(fmaxf(lg[0], lg[1]), lg[2]); const float w0 = __expf(lg[0] - M), w1 = __expf(lg[1] - M), w2 = __expf(lg[2] - M), rs = 1.0f / (w0 + w1 + w2);
        const f32x4 y = (og[0] * w0 + og[1] * w1 + og[2] * w2) * rs;
        if (kk == 0) { u32x2 w; w.x = cvtpk(y[0], y[1]); w.y = cvtpk(y[2], y[3]); *(GAS u32x2*)(Y + (size_t)r * AW + h * 64 + 4 * dp) = w; }
    }
}
__device__ __forceinline__ void spatial_prompt_mfma(Frame& F, const Args& a, const bf16* UV, bf16* Z, const bf16* Wsb, const float* VS, int li) {
    LOCAL_IDS;
    LAS unsigned char* img = F.lds + RING_OFF;
    LAS float* st = (LAS float*)(F.lds + RING_OFF + 126976);
    const int tt = wave & 3, chalf = wave >> 2;
    const float* lng = kin(15) + li * DV; const float* lnb = kin(16) + li * DV;
    for (int u = F.vcu; u < 256; u += F.G) {
        const int cidx = u >> 1, ghalf = u & 1, row0 = cidx * 128;
        int td_ = tid; asm volatile("" : "+v"(td_)); const int c8b = td_ % 48, sr = td_ / 48, cb = c8b * 8;
        const bool builder = td_ < 480;
        v4u x[13]; f32x4 g0, g1, b0, b1;
        { const int ch0 = (ghalf * 4) * 384; const bf16* vp = UV + (size_t)(row0 + sr) * UVW + DV + ch0 + cb;
          if (builder) { g0 = *(const GAS f32x4*)(lng + ch0 + cb); g1 = *(const GAS f32x4*)(lng + ch0 + cb + 4); b0 = *(const GAS f32x4*)(lnb + ch0 + cb); b1 = *(const GAS f32x4*)(lnb + ch0 + cb + 4);
#pragma unroll
              for (int k = 0; k < 13; ++k) x[k] = (sr + 10 * k) < 128 ? *(const GAS v4u*)(vp + (size_t)(10 * k) * UVW) : (v4u){0u, 0u, 0u, 0u}; } }
        __syncthreads();
        { typedef float f32x2 __attribute__((ext_vector_type(2)));
          int t4_ = tid; asm volatile("" : "+v"(t4_)); const int rr = t4_ >> 2, qd = t4_ & 3; const f32x2* vp = (const f32x2*)(VS + ((size_t)(row0 + rr) * 48 + qd * 12) * 2); float s1 = 0.f, s2 = 0.f;
#pragma unroll
          for (int j = 0; j < 12; ++j) { const f32x2 xx = vp[j]; s1 += xx.x; s2 += xx.y; }
          s1 += __shfl_xor(s1, 1); s1 += __shfl_xor(s1, 2); s2 += __shfl_xor(s2, 1); s2 += __shfl_xor(s2, 2);
          const float mean = s1 * (1.0f / DV), var = s2 * (1.0f / DV) - mean * mean;
          if (qd == 0) { st[2 * rr] = mean; st[2 * rr + 1] = __builtin_amdgcn_rsqf(fmaxf(var, 0.f) + LN_EPS); } }
        __syncthreads();
        for (int gi = 0; gi < 4; ++gi) {
            const int gg = ghalf * 4 + gi, ch0 = gg * 384;
            int l5_ = lane; asm volatile("" : "+v"(l5_)); const int tl = l5_ & 31, hh = l5_ >> 5, trbn = ((l5_ >> 4) & 1) * 32 + (l5_ & 3) * 8 + (8 * hh + ((l5_ & 15) >> 2)) * 64;
            const bf16* wp = Wsb + ((size_t)((li * 8 + gg) * 128 + 32 * tt + tl)) * 128 + 8 * hh;
            const float bt = kin(18)[(li * 8 + gg) * 128 + 32 * tt + tl];
            bf16x8 wfr[8];
#pragma unroll
            for (int ks = 0; ks < 8; ++ks) wfr[ks] = *(const GAS bf16x8*)(wp + 16 * ks);
            if (builder) {
#pragma unroll
                for (int k = 0; k < 13; ++k) { const int s = sr + 10 * k;
                    if (s < 128) { const float mean = st[2 * s], rstd = st[2 * s + 1]; v4u o;
                        o.x = pk2((bflo(x[k].x) - mean) * rstd * g0.x + b0.x, (bfhi(x[k].x) - mean) * rstd * g0.y + b0.y); o.y = pk2((bflo(x[k].y) - mean) * rstd * g0.z + b0.z, (bfhi(x[k].y) - mean) * rstd * g0.w + b0.w);
                        o.z = pk2((bflo(x[k].z) - mean) * rstd * g1.x + b1.x, (bfhi(x[k].z) - mean) * rstd * g1.y + b1.y); o.w = pk2((bflo(x[k].w) - mean) * rstd * g1.z + b1.z, (bfhi(x[k].w) - mean) * rstd * g1.w + b1.w);
                        *(LAS v4u*)(img + (cb >> 5) * 8192 + s * 64 + (cb & 31) * 2) = o; } }
            }
            __syncthreads();
            f32x16 acc[6];
#pragma unroll
            for (int ct = 0; ct < 6; ++ct)
#pragma unroll
                for (int e = 0; e < 16; ++e) acc[ct][e] = 0.f;
#pragma unroll
            for (int ks = 0; ks < 8; ++ks) if (ks < 2 * (tt + 1)) {
                const bf16x8 wf = wfr[ks];
#pragma unroll
                for (int ct = 0; ct < 6; ++ct) { const LAS unsigned char* ib = img + (chalf * 6 + ct) * 8192 + ks * 1024 + trbn;
                    const s16x4 lo = vtr(ib), hi = vtr(ib + 256);
                    const bf16x8 vf = (bf16x8){lo[0], lo[1], lo[2], lo[3], hi[0], hi[1], hi[2], hi[3]};
                    acc[ct] = __builtin_amdgcn_mfma_f32_32x32x16_bf16(vf, wf, acc[ct], 0, 0, 0); }
            }
            int ln_ = lane; asm volatile("" : "+v"(ln_));
            v4u uu[12];
#pragma unroll
            for (int k = 0; k < 12; ++k) { const int pc = ln_ + 64 * k, tr = pc / 24, c8 = pc - tr * 24;
                uu[k] = *(const GAS v4u*)(UV + (size_t)(row0 + 32 * tt + tr) * UVW + ch0 + chalf * 192 + c8 * 8); }
            __syncthreads();
            LAS unsigned char* stg = img + wave * 12800;
            {
#pragma unroll
              for (int ct = 0; ct < 6; ++ct)
#pragma unroll
                  for (int a4 = 0; a4 < 4; ++a4) { u32x2 mm; mm.x = cvtpk(acc[ct][4 * a4] + bt, acc[ct][4 * a4 + 1] + bt); mm.y = cvtpk(acc[ct][4 * a4 + 2] + bt, acc[ct][4 * a4 + 3] + bt);
                      *(LAS u32x2*)(stg + tl * 400 + (32 * ct + 8 * a4 + 4 * hh) * 2) = mm; } }
            asm volatile("" ::: "memory");
            if (gi < 3 && builder) {
                int t2_ = tid; asm volatile("" : "+v"(t2_)); const int cb2 = (t2_ % 48) * 8, sr2 = t2_ / 48;
                const int ch1 = ch0 + 384; const bf16* vp = UV + (size_t)(row0 + sr2) * UVW + DV + ch1 + cb2;
                g0 = *(const GAS f32x4*)(lng + ch1 + cb2); g1 = *(const GAS f32x4*)(lng + ch1 + cb2 + 4); b0 = *(const GAS f32x4*)(lnb + ch1 + cb2); b1 = *(const GAS f32x4*)(lnb + ch1 + cb2 + 4);
#pragma unroll
                for (int k = 0; k < 13; ++k) x[k] = (sr2 + 10 * k) < 128 ? *(const GAS v4u*)(vp + (size_t)(10 * k) * UVW) : (v4u){0u, 0u, 0u, 0u}; }
            int l3_ = lane; asm volatile("" : "+v"(l3_));
#pragma unroll
            for (int k = 0; k < 12; ++k) { const int pc = l3_ + 64 * k, tr = pc / 24, c8 = pc - tr * 24;
                const v4u mm = *(const LAS v4u*)(stg + tr * 400 + c8 * 16);
                v4u zz; zz.x = cvtpk(bflo(uu[k].x) * bflo(mm.x), bfhi(uu[k].x) * bfhi(mm.x)); zz.y = cvtpk(bflo(uu[k].y) * bflo(mm.y), bfhi(uu[k].y) * bfhi(mm.y));
                zz.z = cvtpk(bflo(uu[k].z) * bflo(mm.z), bfhi(uu[k].z) * bfhi(mm.z)); zz.w = cvtpk(bflo(uu[k].w) * bflo(mm.w), bfhi(uu[k].w) * bfhi(mm.w));
                *(GAS v4u*)(Z + (size_t)(row0 + 32 * tt + tr) * DV + ch0 + chalf * 192 + c8 * 8) = zz; }
            __syncthreads();
        }
    }
}
template <int MODE>
__device__ __forceinline__ void sample_gemm(Frame& F, const bf16* A, const bf16* Bt, int N, int K, float* X, bf16* XB, float* SS, float scale, bf16* UVo) {
    LOCAL_IDS;
    LAS float* part = (LAS float*)(F.lds + RING_OFF);
    const int fr = lane & 15, kq = lane >> 4;
    const int ntile = 8 * (N >> 6), ksl = K >> 3, nst = ksl >> 5;
    for (int tile = F.vcu; tile < ntile; tile += F.G) {
        const int rf = tile & 7, ct = tile >> 3;
        float rs_pre = 0.f; if (MODE == 1) rs_pre = pg8::row_rstd32(SS, 16 * rf + (tid >> 5));
        const bf16* ap = A + (size_t)(16 * rf + fr) * K + wave * ksl + 8 * kq;
        const bf16* bp = Bt + (size_t)(64 * ct + fr) * K + wave * ksl + 8 * kq;
        f32x4 acc[4];
#pragma unroll
        for (int cf = 0; cf < 4; ++cf) acc[cf] = (f32x4){0.f, 0.f, 0.f, 0.f};
        for (int s0 = 0; s0 < nst; s0 += 4) {
            bf16x8 af[4], bfr[4][4];
#pragma unroll
            for (int s = 0; s < 4; ++s) if (s0 + s < nst) { af[s] = *(const GAS bf16x8*)(ap + 32 * (s0 + s));
#pragma unroll
                for (int cf = 0; cf < 4; ++cf) bfr[s][cf] = *(const GAS bf16x8*)(bp + (size_t)cf * 16 * K + 32 * (s0 + s)); }
            asm volatile("" ::: "memory");
#pragma unroll
            for (int s = 0; s < 4; ++s) if (s0 + s < nst) asm volatile("" : "+v"(af[s]), "+v"(bfr[s][0]), "+v"(bfr[s][1]), "+v"(bfr[s][2]), "+v"(bfr[s][3]));
#pragma unroll
            for (int s = 0; s < 4; ++s) if (s0 + s < nst) {
#pragma unroll
                for (int cf = 0; cf < 4; ++cf) acc[cf] = __builtin_amdgcn_mfma_f32_16x16x32_bf16(af[s], bfr[s][cf], acc[cf], 0, 0, 0); }
        }
#pragma unroll
        for (int cf = 0; cf < 4; ++cf)
#pragma unroll
            for (int e = 0; e < 4; ++e) part[(wave * 16 + 4 * kq + e) * 68 + 16 * cf + fr] = acc[cf][e];
        __syncthreads();
        { const int r = tid >> 5, c = 2 * (tid & 31); float s0 = 0.f, s1 = 0.f;
#pragma unroll
          for (int w = 0; w < 8; ++w) { s0 += part[(w * 16 + r) * 68 + c]; s1 += part[(w * 16 + r) * 68 + c + 1]; }
          const int grow = MP + 16 * rf + r, gcol = 64 * ct + c;
          if (MODE == 0) {
              const unsigned xo = *(const GAS unsigned*)(XB + (size_t)grow * DM + gcol);
              const unsigned w = cvtpk(bflo(xo) + scale * s0, bfhi(xo) + scale * s1);
              *(GAS unsigned*)(XB + (size_t)grow * DM + gcol) = w;
              float ss = bflo(w) * bflo(w) + bfhi(w) * bfhi(w);
              ss += __shfl_xor(ss, 1); ss += __shfl_xor(ss, 2); ss += __shfl_xor(ss, 4); ss += __shfl_xor(ss, 8); ss += __shfl_xor(ss, 16);
              if ((tid & 31) == 0) SS[(size_t)grow * 16 + ct] = ss;
          } else {
              const float rs = rs_pre;
              *(GAS unsigned*)(UVo + (size_t)grow * UVW + gcol) = cvtpk(pg8::gelu_tanh_f(s0 * rs), pg8::gelu_tanh_f(s1 * rs));
          } }
        __syncthreads();
    }
}

template <int NST>
__device__ __forceinline__ void sample_resid(Frame& F, const bf16* A, const bf16* Bt, float* SSS, bf16* XB, float scale, const XcdBarrier* seam = nullptr) {
    LOCAL_IDS;
    constexpr int K = NST * 256;
    LAS float* part = (LAS float*)(F.lds + RING_OFF);
    const int fr = lane & 15, kq = lane >> 4;
    for (int tile = F.vcu; tile < 256; tile += F.G) {
        const int rf = tile & 7, ct = tile >> 3;
        const bf16* ap = A + (size_t)(16 * rf + fr) * K + wave * (NST * 32) + 8 * kq;
        const bf16* bp = Bt + (size_t)(32 * ct + fr) * K + wave * (NST * 32) + 8 * kq;
        bf16x8 af[NST], b0[NST], b1[NST];
        const bool split = seam != nullptr && tile == F.vcu;
        pg8::StaticOrder Sg; Sg.init(MP, DM, F.G, (int)blockIdx.x);
        if (split) { xcd_barrier_head(); pg8::gemm_prefetch_b<true>(F.lds + RING_OFF, Bt, K, Sg, 0); }
        if (!split || wave != 0) {
#pragma unroll
            for (int s = 0; s < NST; ++s) { b0[s] = *(const GAS bf16x8*)(bp + 32 * s); b1[s] = *(const GAS bf16x8*)(bp + (size_t)16 * K + 32 * s); } }
        if (split) { asm volatile("" ::: "memory"); xcd_barrier_tail(*seam); }
        if (split) pg8::gemm_prefetch_b<true>(F.lds + RING_OFF, Bt, K, Sg, 1);
        if (split && wave == 0) {
#pragma unroll
            for (int s = 0; s < NST; ++s) { b0[s] = *(const GAS bf16x8*)(bp + 32 * s); b1[s] = *(const GAS bf16x8*)(bp + (size_t)16 * K + 32 * s); } }
        const unsigned short xo_pre = XB[(size_t)(MP + 16 * rf + (tid >> 5)) * DM + 32 * ct + (tid & 31)];
#pragma unroll
        for (int s = 0; s < NST; ++s) af[s] = *(const GAS bf16x8*)(ap + 32 * s);
        asm volatile("" ::: "memory");
#pragma unroll
        for (int s = 0; s < NST; ++s) asm volatile("" : "+v"(af[s]), "+v"(b0[s]), "+v"(b1[s]));
        f32x4 acc0 = (f32x4){0.f, 0.f, 0.f, 0.f}, acc1 = (f32x4){0.f, 0.f, 0.f, 0.f};
#pragma unroll
        for (int s = 0; s < NST; ++s) { acc0 = __builtin_amdgcn_mfma_f32_16x16x32_bf16(af[s], b0[s], acc0, 0, 0, 0); acc1 = __builtin_amdgcn_mfma_f32_16x16x32_bf16(af[s], b1[s], acc1, 0, 0, 0); }
#pragma unroll
        for (int e = 0; e < 4; ++e) { part[(wave * 16 + 4 * kq + e) * 36 + fr] = acc0[e]; part[(wave * 16 + 4 * kq + e) * 36 + 16 + fr] = acc1[e]; }
        __syncthreads();
        { const int r = tid >> 5, c = tid & 31; float sum = 0.f;
#pragma unroll
          for (int w = 0; w < 8; ++w) sum += part[(w * 16 + r) * 36 + c];
          const int grow = MP + 16 * rf + r, gcol = 32 * ct + c;
          const unsigned short xo = xo_pre;
          const unsigned short xn = (unsigned short)f2bf(bf2f(xo) + scale * sum);
          XB[(size_t)grow * DM + gcol] = xn;
          float ss = bf2f(xn) * bf2f(xn);
          ss += __shfl_xor(ss, 1); ss += __shfl_xor(ss, 2); ss += __shfl_xor(ss, 4); ss += __shfl_xor(ss, 8); ss += __shfl_xor(ss, 16);
          if (c == 0) SSS[(size_t)(16 * rf + r) * 32 + ct] = ss; }
        __syncthreads();
    }
    if (seam != nullptr && F.vcu >= 256) xcd_barrier(*seam);
}
constexpr int NPH = 34;
#ifndef PROBE_MASK
#define PROBE_MASK 0
#endif
#define REP(bit) (((PROBE_MASK) >> (bit)) & 1 ? 2 : 1)
#ifndef MK_N_LAUNCHES
#define MK_N_LAUNCHES 1
#endif
__global__ void __launch_bounds__(NTHREADS, 2) fwd(Args args) {
    extern __shared__ __attribute__((aligned(16))) unsigned char lds[];
    Frame F;
    F.lds = (LAS unsigned char*)lds;
    F.MISC = (volatile LAS unsigned*)(F.lds + MISC_OFF);
    F.G = gridDim.x; { const int bx = blockIdx.x; F.vcu = (F.G % 8 == 0) ? (bx % 8) * (F.G / 8) + bx / 8 : bx; }
    unsigned char* ws = kws();
    F.ctl = (gu32*)(ws + WS_CTL);
    for (int u = threadIdx.x; u < (LDS_BYTES - LDSCTL_OFF) / 4; u += NTHREADS) ((LAS unsigned*)(F.lds + LDSCTL_OFF))[u] = 0u;
    __syncthreads();
    XcdBarrier bar; bar.bar = (unsigned*)(F.ctl + CW_BAR); bar.x = 0; bar.st = nullptr;
    if (MK_N_LAUNCHES == 1) bar = xcd_barrier_post((unsigned*)(F.ctl + CW_BAR), F.MISC + 8);
#if MK_N_LAUNCHES == 1
    constexpr int lo = 0, hi = NPH;
#else
    const int lo = args.ph_lo, hi = args.ph_hi;
#endif
#define IN(k) (lo <= (k) && (k) < hi)
#define SEAM(k) do { if (IN((k) + 1)) xcd_barrier(bar); } while (0)
    float* X = (float*)(ws + WS_X); bf16* XB = (bf16*)(ws + WS_XB); float* SS = (float*)(ws + WS_SS);
    bool preB = false;
#define PREFETCH_B(k, Bt_, Mr, Nc, Kd) do { if (IN(k)) { __syncthreads();     pg8::StaticOrder Sn; Sn.init((Mr), (Nc), opq(F.G), opq((int)blockIdx.x)); pg8::gemm_prefetch_b<true>(F.lds + RING_OFF, (const bf16*)(Bt_), (Kd), Sn); preB = true; } } while (0)
#define TAKE_PRE(v) const bool v = preB; preB = false
    bf16* BIG = (bf16*)(ws + WS_BIG); bf16* YZ = (bf16*)(ws + WS_YZ);

    if (IN(0)) { for (int rep = 0; rep < REP(0); ++rep) p0_prologue(F, args); SEAM(0); }
    int conv_base = CV_PRO;
    for (int L = 0; L < 4; ++L) {
        const int pb = 1 + 8 * L, li = L >> 1;
        if (IN(pb + 0)) {
            pg8::Gemm g{XB, (const bf16*)(ws + WS_WIN1 + L * SZ_WIN), MROWS, NIN, DM}; pg8::StaticOrder S; S.init(MROWS, NIN, opq(F.G), opq((int)blockIdx.x));
            pg8::fill_rstd_table(F.lds, S, SS, (const float*)(ws + WS_SSS)); pg8::EpiSwiglu E{BIG, (const PG8_LAS float*)(F.lds + pg8::RS_TAB_OFF), DFF};
            TAKE_PRE(pre);
            for (int rep = 0; rep < REP(1); ++rep) pg8::gemm_phase<pg8::EpiSwiglu, pg8::StaticOrder, true, true>(F.lds + RING_OFF, g, S, E, pre && rep == 0);
            conv_base = convert_slack(F, (MROWS / 256) * (NIN / 256), conv_base);
            conv_base = cv_guard(F, conv_base, cv_need(L, 1));
            SEAM(pb + 0);
        }
        if (IN(pb + 1)) {
            for (int rep = 0; rep < REP(10); ++rep) sample_resid<11>(F, BIG + (size_t)MP * DFF, (const bf16*)(ws + WS_WOUT1 + L * SZ_WOUT), (float*)(ws + WS_SSS), XB, (rep == REP(10) - 1 ? 0.5f : 0.0f));
            pg8::Gemm g{BIG, (const bf16*)(ws + WS_WOUT1 + L * SZ_WOUT), MP, DM, DFF}; pg8::StaticOrder S; S.init(MP, DM, opq(F.G), opq((int)blockIdx.x));
            TAKE_PRE(pre);
            for (int rep = 0; rep < REP(2); ++rep) { pg8::EpiResid E{X, XB, SS, rep == REP(2) - 1 ? 0.5f : 0.0f};
            pg8::gemm_phase<pg8::EpiResid, pg8::StaticOrder, true, true>(F.lds + RING_OFF, g, S, E, pre && rep == 0); }
            conv_base = cv_guard(F, conv_base, cv_need(L, 2));
            SEAM(pb + 1);
        }
        if ((L & 1) == 0) {
            if (IN(pb + 2)) {
                pg8::Gemm g{XB, (const bf16*)(ws + WS_WQKV + li * SZ_WQKV), MROWS, QW, DM}; pg8::StaticOrder S; S.init(MROWS, QW, opq(F.G), opq((int)blockIdx.x));
                pg8::fill_rstd_table(F.lds, S, SS, (const float*)(ws + WS_SSS)); pg8::EpiQkv E{BIG, (const PG8_LAS float*)(F.lds + pg8::RS_TAB_OFF), kout(), li};
                TAKE_PRE(pre);
                for (int rep = 0; rep < REP(3); ++rep) pg8::gemm_phase<pg8::EpiQkv, pg8::StaticOrder, true, true>(F.lds + RING_OFF, g, S, E, pre && rep == 0);
                conv_base = convert_slack(F, (MROWS / 256) * (QW / 256), conv_base);
                SEAM(pb + 2);
            }
            if (IN(pb + 3)) { for (int rep = 0; rep < REP(4); ++rep) attn_prompt_shared(F, BIG, (bf16*)(ws + WS_YZ + 20 * MiB), (float*)(ws + WS_YZ + 72 * MiB)); for (int rep = 0; rep < REP(5); ++rep) attn_sample_v2(F, args, BIG, (bf16*)(ws + WS_YZ + 69 * MiB), (float*)(ws + WS_YZ + 72 * MiB), li); SEAM(pb + 3); }
            if (IN(pb + 4)) { for (int rep = 0; rep < REP(6); ++rep) attn_merge(F, (const bf16*)(ws + WS_YZ + 20 * MiB), (const bf16*)(ws + WS_YZ + 69 * MiB), (const float*)(ws + WS_YZ + 72 * MiB), YZ); conv_base = cv_guard(F, conv_base, cv_need(L, 5)); SEAM(pb + 4); }
            if (IN(pb + 5)) {
                for (int rep = 0; rep < REP(10); ++rep) sample_resid<2>(F, YZ + (size_t)MP * AW, (const bf16*)(ws + WS_WOA + li * SZ_WOA), (float*)(ws + WS_SSS), XB, (rep == REP(10) - 1 ? 1.0f : 0.0f));
                pg8::Gemm g{YZ, (const bf16*)(ws + WS_WOA + li * SZ_WOA), MP, DM, AW}; pg8::StaticOrder S; S.init(MP, DM, opq(F.G), opq((int)blockIdx.x));
                TAKE_PRE(pre);
                for (int rep = 0; rep < REP(7); ++rep) { pg8::EpiResid E{X, XB, SS, rep == REP(7) - 1 ? 1.0f : 0.0f};
                pg8::gemm_phase<pg8::EpiResid, pg8::StaticOrder, true, true>(F.lds + RING_OFF, g, S, E, pre && rep == 0); }
                conv_base = cv_guard(F, conv_base, cv_need(L, 6));
                SEAM(pb + 5);
            }
        } else {
            if (IN(pb + 2)) {
                for (int rep = 0; rep < REP(10); ++rep) sample_gemm<1>(F, XB + (size_t)MP * DM, (const bf16*)(ws + WS_WUV + li * SZ_WUV), UVW, DM, nullptr, nullptr, (float*)(ws + WS_SSS), 0.f, BIG);
                pg8::Gemm g{XB, (const bf16*)(ws + WS_WUV + li * SZ_WUV), MP, UVW, DM}; pg8::StaticOrder S; S.init(MP, UVW, opq(F.G), opq((int)blockIdx.x));
                pg8::fill_rstd_table(F.lds, S, SS, (const float*)(ws + WS_SSS)); pg8::EpiUv E{BIG, (const PG8_LAS float*)(F.lds + pg8::RS_TAB_OFF), (float*)(ws + WS_VS)};
                TAKE_PRE(pre);
                for (int rep = 0; rep < REP(8); ++rep) pg8::gemm_phase<pg8::EpiUv, pg8::StaticOrder, true, true>(F.lds + RING_OFF, g, S, E, pre && rep == 0);
                SEAM(pb + 2);
            }
            if (IN(pb + 3)) { for (int rep = 0; rep < REP(9); ++rep) spatial_prompt_mfma(F, args, BIG, YZ, (const bf16*)(ws + WS_WSB), (const float*)(ws + WS_VS), li); for (int rep = 0; rep < REP(11); ++rep) spatial_sample_v1(F, args, BIG, YZ, li); conv_base = cv_guard(F, conv_base, cv_need(L, 5)); if (IN(pb + 5)) xcd_barrier(bar); }
            if (IN(pb + 5)) {
                for (int rep = 0; rep < REP(10); ++rep) sample_resid<12>(F, YZ + (size_t)MP * DV, (const bf16*)(ws + WS_WOB + li * SZ_WOB), (float*)(ws + WS_SSS), XB, (rep == REP(10) - 1 ? 1.0f : 0.0f));
                pg8::Gemm g{YZ, (const bf16*)(ws + WS_WOB + li * SZ_WOB), MP, DM, DV}; pg8::StaticOrder S; S.init(MP, DM, opq(F.G), opq((int)blockIdx.x));
                TAKE_PRE(pre);
                for (int rep = 0; rep < REP(7); ++rep) { pg8::EpiResid E{X, XB, SS, rep == REP(7) - 1 ? 1.0f : 0.0f};
                pg8::gemm_phase<pg8::EpiResid, pg8::StaticOrder, true, true>(F.lds + RING_OFF, g, S, E, pre && rep == 0); }
                conv_base = cv_guard(F, conv_base, cv_need(L, 6));
                SEAM(pb + 5);
            }
        }
        if (IN(pb + 6)) {
            pg8::Gemm g{XB, (const bf16*)(ws + WS_WIN2 + L * SZ_WIN), MROWS, NIN, DM}; pg8::StaticOrder S; S.init(MROWS, NIN, opq(F.G), opq((int)blockIdx.x));
            pg8::fill_rstd_table(F.lds, S, SS, (const float*)(ws + WS_SSS)); pg8::EpiSwiglu E{BIG, (const PG8_LAS float*)(F.lds + pg8::RS_TAB_OFF), DFF};
            TAKE_PRE(pre);
            for (int rep = 0; rep < REP(1); ++rep) pg8::gemm_phase<pg8::EpiSwiglu, pg8::StaticOrder, true, true>(F.lds + RING_OFF, g, S, E, pre && rep == 0);
            conv_base = convert_slack(F, (MROWS / 256) * (NIN / 256), conv_base);
            conv_base = cv_guard(F, conv_base, cv_need(L, 7));
            SEAM(pb + 6);
        }
        if (IN(pb + 7)) {
            for (int rep = 0; rep < REP(10); ++rep) sample_resid<11>(F, BIG + (size_t)MP * DFF, (const bf16*)(ws + WS_WOUT2 + L * SZ_WOUT), (float*)(ws + WS_SSS), XB, (rep == REP(10) - 1 ? 0.5f : 0.0f));
            pg8::Gemm g{BIG, (const bf16*)(ws + WS_WOUT2 + L * SZ_WOUT), MP, DM, DFF}; pg8::StaticOrder S; S.init(MP, DM, opq(F.G), opq((int)blockIdx.x));
            TAKE_PRE(pre);
            for (int rep = 0; rep < REP(2); ++rep) { pg8::EpiResid E{X, XB, SS, rep == REP(2) - 1 ? 0.5f : 0.0f};
            pg8::gemm_phase<pg8::EpiResid, pg8::StaticOrder, true, true>(F.lds + RING_OFF, g, S, E, pre && rep == 0); }
            if (L < 3) conv_base = cv_guard(F, conv_base, cv_need(L + 1, 0));
            SEAM(pb + 7);
        }
    }
    if (IN(33)) final_norm(F, args);
#undef IN
#undef SEAM
}

extern "C" void kernel_launch(void* const* d_in, const int* in_sizes, int n_in, void* d_out, int out_size, void* d_ws, size_t ws_size, hipStream_t stream) {
    static int grid = 0;
    if (grid == 0) {
        if (n_in != 21 || out_size != (int)O_END || ws_size < WS_END) { fprintf(stderr, "kernel_launch: unexpected problem: n_in %d out %d ws %zu (need %zu); nothing launched\n", n_in, out_size, ws_size, (size_t)WS_END); grid = -1; return; }
        int dev = 0, cus = 0, per_cu = 0;
        if (hipGetDevice(&dev) != hipSuccess || hipDeviceGetAttribute(&cus, hipDeviceAttributeMultiprocessorCount, dev) != hipSuccess) { grid = -1; return; }
        if (hipFuncSetAttribute((const void*)fwd, hipFuncAttributeMaxDynamicSharedMemorySize, LDS_BYTES) != hipSuccess) { fprintf(stderr, "kernel_launch: hipFuncSetAttribute failed\n"); grid = -1; return; }
        if (hipOccupancyMaxActiveBlocksPerMultiprocessor(&per_cu, (const void*)fwd, NTHREADS, LDS_BYTES) != hipSuccess || per_cu < 1) { fprintf(stderr, "kernel_launch: occupancy query says %d blocks per CU\n", per_cu); }
        (void)hipGetLastError();
        grid = cus;
    }
    if (grid < 0) return;
    if (hipMemsetAsync((char*)d_ws + WS_CTL, 0, CTL_ZERO_BYTES, stream) != hipSuccess) return;
    Args a{};
    for (int i = 0; i < 21; ++i) a.in[i] = (const float*)d_in[i];
    a.out = (float*)d_out; a.ws = (unsigned char*)d_ws;
    if (MK_N_LAUNCHES == 1) { a.ph_lo = 0; a.ph_hi = NPH; hipLaunchKernelGGL(fwd, dim3(grid), dim3(NTHREADS), LDS_BYTES, stream, a); }
    else for (int p = 0; p < NPH; ++p) { a.ph_lo = p; a.ph_hi = p + 1; hipLaunchKernelGGL(fwd, dim3(grid), dim3(NTHREADS), LDS_BYTES, stream, a); }
}
```
